# Optimizing an MI355X kernel written in HIP

```python
import jax, jax.numpy as jnp
from jax import lax
import numpy as np

D_MODEL = 1024
BATCH = 8
SEQ = 2048
DEPTH = 4
DEC_BATCH = 128
DEC_SEQ = 4
PAST_LEN = 16384
PAGE_SIZE = 128

N_MIXERS = 4
D_FF = 2816
FFN_HALF = 0.5
EPS = 1e-6
CONV_A_WIDTH = 31
CONV_B_WIDTH = 3
GMLP_WIDTH = D_MODEL
CHUNK = 128
C_HEADS = 8
C_HEAD_DIM = GMLP_WIDTH // C_HEADS
POOL_WINDOWS = (2, 4, 8, 16)
POOL_GROUPS = len(POOL_WINDOWS)
POOL_GROUP_DIM = D_MODEL // POOL_GROUPS
POOL_PAD = max(POOL_WINDOWS) - 1

kernel_name = "hybrid_conv_gmlp_pool_decoder_step"


def rmsnorm(x, g):
    xf = x.astype(jnp.float32)
    y = xf * lax.rsqrt(jnp.mean(xf * xf, axis=-1, keepdims=True) + EPS)
    return (y * g.astype(jnp.float32)).astype(x.dtype)


def layernorm(x, g, b):
    xf = x.astype(jnp.float32)
    xc = xf - jnp.mean(xf, axis=-1, keepdims=True)
    y = xc * lax.rsqrt(jnp.mean(xc * xc, axis=-1, keepdims=True) + EPS)
    return (y * g.astype(jnp.float32) + b.astype(jnp.float32)).astype(x.dtype)


def depthwise_conv(ext, w):
    return lax.conv_general_dilated(
        ext, w.astype(ext.dtype)[:, None, :], window_strides=(1,), padding="VALID",
        dimension_numbers=("NWC", "WIO", "NWC"), feature_group_count=ext.shape[-1])


def swiglu(x, w_in, w_down):
    a = x @ w_in
    gate, up = jnp.split(a, 2, axis=-1)
    return (jax.nn.silu(gate) * up) @ w_down


def conformer_conv(x, buf, w_in, conv_w, conv_b, ln_g, ln_b, w_out):
    a = x @ w_in
    glu = a[..., :D_MODEL] * jax.nn.sigmoid(a[..., D_MODEL:])
    ext = jnp.concatenate([buf.astype(glu.dtype), glu], axis=1)
    c = depthwise_conv(ext, conv_w) + conv_b
    c = jax.nn.silu(layernorm(c, ln_g, ln_b))
    return c @ w_out, ext[:, -(CONV_A_WIDTH - 1):]


def short_gated_conv(x, buf, w_in, conv_w, w_out):
    p = x @ w_in
    b_gate, c_gate, xin = jnp.split(p, 3, axis=-1)
    z = c_gate * xin
    ext = jnp.concatenate([buf.astype(z.dtype), z], axis=1)
    c = depthwise_conv(ext, conv_w)
    return (b_gate * c) @ w_out, ext[:, -(CONV_B_WIDTH - 1):]


def chunk_spatial(v, ws, bs):
    bsz, length, _ = v.shape
    pad = (-length) % CHUNK
    vp = jnp.pad(v, ((0, 0), (0, pad), (0, 0)))
    n_chunks = (length + pad) // CHUNK
    vp = vp.reshape(bsz, n_chunks, CHUNK, C_HEADS, C_HEAD_DIM)
    mask = jnp.tril(jnp.ones((CHUNK, CHUNK), dtype=bool))
    wm = jnp.where(mask[None], ws, jnp.zeros_like(ws))
    out = jnp.einsum("hij,bnjhc->bnihc", wm, vp) + bs.T[None, None, :, :, None]
    return out.reshape(bsz, n_chunks * CHUNK, GMLP_WIDTH)[:, :length]


def chunk_gmlp(x, w_in, ln_g, ln_b, ws, bs, w_out):
    z = jax.nn.gelu(x @ w_in, approximate=False)
    u, v = jnp.split(z, 2, axis=-1)
    v = layernorm(v, ln_g, ln_b)
    s = chunk_spatial(v, ws, bs)
    return (u * s) @ w_out, v


def multiscale_pool(x, buf, pos0, w_group, scale):
    bsz, length, _ = x.shape
    ext = jnp.concatenate([buf.astype(x.dtype), x], axis=1)
    xf = ext.astype(jnp.float32)
    cs = jnp.concatenate([jnp.zeros((bsz, 1, D_MODEL), jnp.float32), jnp.cumsum(xf, axis=1)], axis=1)
    end = cs[:, POOL_PAD + 1:]
    pos = pos0 + jnp.arange(length)
    pooled = []
    for g, w in enumerate(POOL_WINDOWS):
        sl = slice(g * POOL_GROUP_DIM, (g + 1) * POOL_GROUP_DIM)
        start = cs[:, POOL_PAD + 1 - w: POOL_PAD + 1 - w + length, sl]
        cnt = jnp.minimum(w, pos + 1).astype(jnp.float32)[None, :, None]
        pooled.append((end[..., sl] - start) / cnt)
    diff = jnp.concatenate(pooled, axis=-1) - x.astype(jnp.float32)
    diff = diff.astype(x.dtype).reshape(bsz, length, POOL_GROUPS, POOL_GROUP_DIM)
    y = jnp.einsum("blgc,gcd->blgd", diff, w_group).reshape(bsz, length, D_MODEL)
    return y * scale, ext[:, -POOL_PAD:]


def trunk(x, buf_a, buf_b, buf_pool, pos0, norm_g, ffn_w_in, ffn_w_down,
          a_w_in, a_conv_w, a_conv_b, a_ln_g, a_ln_b, a_w_out,
          b_w_in, b_conv_w, b_w_out,
          c_w_in, c_ln_g, c_ln_b, c_ws, c_bs, c_w_out,
          d_w_group, d_scale):
    h = x
    st_a = st_b = st_c = st_d = None
    for i in range(DEPTH):
        g = norm_g[i]
        f = swiglu(rmsnorm(h, g[0]), ffn_w_in[i, 0], ffn_w_down[i, 0])
        h = h + FFN_HALF * rmsnorm(f, g[1])
        xm = rmsnorm(h, g[2])
        kind = i % N_MIXERS
        if kind == 0:
            m, st_a = conformer_conv(xm, buf_a, a_w_in, a_conv_w, a_conv_b, a_ln_g, a_ln_b, a_w_out)
        elif kind == 1:
            m, st_b = short_gated_conv(xm, buf_b, b_w_in, b_conv_w, b_w_out)
        elif kind == 2:
            m, st_c = chunk_gmlp(xm, c_w_in, c_ln_g, c_ln_b, c_ws, c_bs, c_w_out)
        else:
            m, st_d = multiscale_pool(xm, buf_pool, pos0, d_w_group, d_scale)
        h = h + rmsnorm(m, g[3])
        f = swiglu(rmsnorm(h, g[4]), ffn_w_in[i, 1], ffn_w_down[i, 1])
        h = h + FFN_HALF * rmsnorm(f, g[5])
    return h, st_a, st_b, st_c, st_d


def setup_inputs(seed: int = 0) -> dict:
    key = jax.random.key(seed)
    ks = jax.random.split(key, 26)

    def nrm(k, shape, scale):
        return jax.random.normal(k, shape, jnp.float32) * scale

    D = D_MODEL
    return {
        "x_prompt": nrm(ks[0], (BATCH, SEQ, D), 1.0),
        "x_sample": nrm(ks[1], (DEC_BATCH, DEC_SEQ, D), 1.0),
        "state_conv_a": nrm(ks[2], (DEC_BATCH, CONV_A_WIDTH - 1, D), 0.5),
        "state_conv_b": nrm(ks[3], (DEC_BATCH, CONV_B_WIDTH - 1, D), 0.5),
        "state_pool": nrm(ks[4], (DEC_BATCH, POOL_PAD, D), 1.0),
        "norm_g": 1.0 + nrm(ks[5], (DEPTH, 6, D), 0.05),
        "ffn_w_in": nrm(ks[6], (DEPTH, 2, D, 2 * D_FF), D ** -0.5),
        "ffn_w_down": nrm(ks[7], (DEPTH, 2, D_FF, D), D_FF ** -0.5),
        "a_w_in": nrm(ks[8], (D, 2 * D), D ** -0.5),
        "a_conv_w": nrm(ks[9], (CONV_A_WIDTH, D), CONV_A_WIDTH ** -0.5),
        "a_conv_b": nrm(ks[10], (D,), 0.02),
        "a_ln_g": 1.0 + nrm(ks[11], (D,), 0.05),
        "a_ln_b": nrm(ks[12], (D,), 0.02),
        "a_w_out": nrm(ks[13], (D, D), D ** -0.5),
        "b_w_in": nrm(ks[14], (D, 3 * D), D ** -0.5),
        "b_conv_w": nrm(ks[15], (CONV_B_WIDTH, D), CONV_B_WIDTH ** -0.5),
        "b_w_out": nrm(ks[16], (D, D), D ** -0.5),
        "c_w_in": nrm(ks[17], (D, 2 * GMLP_WIDTH), D ** -0.5),
        "c_ln_g": 1.0 + nrm(ks[18], (GMLP_WIDTH,), 0.05),
        "c_ln_b": nrm(ks[19], (GMLP_WIDTH,), 0.02),
        "c_ws": nrm(ks[20], (C_HEADS, CHUNK, CHUNK), CHUNK ** -0.5),
        "c_bs": 1.0 + nrm(ks[21], (C_HEADS, CHUNK), 0.1),
        "c_w_out": nrm(ks[22], (GMLP_WIDTH, D), GMLP_WIDTH ** -0.5),
        "d_w_group": nrm(ks[23], (POOL_GROUPS, POOL_GROUP_DIM, POOL_GROUP_DIM), POOL_GROUP_DIM ** -0.5),
        "d_scale": 1.0 + nrm(ks[24], (D,), 0.1),
    }


def reference(x_prompt, x_sample, state_conv_a, state_conv_b, state_pool,
              norm_g, ffn_w_in, ffn_w_down,
              a_w_in, a_conv_w, a_conv_b, a_ln_g, a_ln_b, a_w_out,
              b_w_in, b_conv_w, b_w_out,
              c_w_in, c_ln_g, c_ln_b, c_ws, c_bs, c_w_out,
              d_w_group, d_scale):
    weights = (norm_g, ffn_w_in, ffn_w_down,
               a_w_in, a_conv_w, a_conv_b, a_ln_g, a_ln_b, a_w_out,
               b_w_in, b_conv_w, b_w_out,
               c_w_in, c_ln_g, c_ln_b, c_ws, c_bs, c_w_out,
               d_w_group, d_scale)
    bp = x_prompt.shape[0]
    zero_a = jnp.zeros((bp, CONV_A_WIDTH - 1, D_MODEL), x_prompt.dtype)
    zero_b = jnp.zeros((bp, CONV_B_WIDTH - 1, D_MODEL), x_prompt.dtype)
    zero_pool = jnp.zeros((bp, POOL_PAD, D_MODEL), x_prompt.dtype)
    y_prompt, sa_p, sb_p, _, sp_p = trunk(x_prompt, zero_a, zero_b, zero_pool, 0, *weights)
    y_sample, sa_s, sb_s, sc_s, sp_s = trunk(x_sample, state_conv_a, state_conv_b, state_pool, PAST_LEN, *weights)
    return (y_prompt, y_sample, sa_p, sa_s, sb_p, sb_s, sc_s, sp_p, sp_s)
```

```cpp
#include <hip/hip_runtime.h>
#include <hip/hip_cooperative_groups.h>
#include <cstdio>
#include <cstdint>
namespace cg = cooperative_groups;

#define LAS __attribute__((address_space(3)))
typedef unsigned short bf16_t;
typedef short bf16x8 __attribute__((ext_vector_type(8)));
typedef float f32x4 __attribute__((ext_vector_type(4)));
typedef float f32x2 __attribute__((ext_vector_type(2)));
typedef unsigned u32x4 __attribute__((ext_vector_type(4)));
typedef unsigned u32x2 __attribute__((ext_vector_type(2)));

constexpr int DM = 1024, DFF = 2816, TP = 16384, TS = 512, NTOK = TP + TS, NLAYER = 4;
constexpr float EPS = 1e-6f;
constexpr int NTHREADS = 512, NWAVES = 8;

constexpr size_t O_Y = 0;
constexpr size_t O_SA_P = (size_t)NTOK * DM;
constexpr size_t O_SA_S = O_SA_P + (size_t)8 * 30 * DM;
constexpr size_t O_SB_P = O_SA_S + (size_t)128 * 30 * DM;
constexpr size_t O_SB_S = O_SB_P + (size_t)8 * 2 * DM;
constexpr size_t O_SC_S = O_SB_S + (size_t)128 * 2 * DM;
constexpr size_t O_SP_P = O_SC_S + (size_t)128 * 4 * DM;
constexpr size_t O_SP_S = O_SP_P + (size_t)8 * 15 * DM;
constexpr size_t O_END = O_SP_S + (size_t)128 * 15 * DM;

constexpr size_t WS_BAR = 0;
constexpr size_t WS_W_FFN_IN = 16384;
constexpr size_t SZ_FFN_IN = (size_t)2 * DFF * DM * 2;
constexpr size_t WS_W_FFN_DN = WS_W_FFN_IN + 8 * SZ_FFN_IN;
constexpr size_t SZ_FFN_DN = (size_t)DM * DFF * 2;
constexpr size_t WS_W_A_IN = WS_W_FFN_DN + 8 * SZ_FFN_DN;
constexpr size_t WS_W_A_OUT = WS_W_A_IN + (size_t)2048 * 1024 * 2;
constexpr size_t WS_W_B_IN = WS_W_A_OUT + (size_t)1024 * 1024 * 2;
constexpr size_t WS_W_B_OUT = WS_W_B_IN + (size_t)3072 * 1024 * 2;
constexpr size_t WS_W_C_IN = WS_W_B_OUT + (size_t)1024 * 1024 * 2;
constexpr size_t WS_W_C_OUT = WS_W_C_IN + (size_t)2048 * 1024 * 2;
constexpr size_t WS_W_D = WS_W_C_OUT + (size_t)1024 * 1024 * 2;
constexpr size_t WS_HB = WS_W_D + (size_t)1024 * 256 * 2;
constexpr size_t WS_ACT = WS_HB + (size_t)NTOK * DM * 2;
constexpr size_t WS_F = WS_ACT + (size_t)NTOK * DFF * 2;
constexpr size_t WS_FX = WS_F + (size_t)NTOK * DM * 4;
constexpr size_t WS_MT = WS_FX + (size_t)10 * TS * DM * 4;
constexpr size_t WS_END = WS_MT + (size_t)NTOK * 3072 * 4;

constexpr int LDS_BYTES = 131072 + 64;

struct Params { const float* in[25]; float* out; unsigned char* ws; };
typedef const Params __attribute__((address_space(4)))* KP;

__device__ __forceinline__ unsigned cvt_pk_bf16(float lo, float hi) { unsigned r; asm volatile("v_cvt_pk_bf16_f32 %0, %1, %2" : "=v"(r) : "v"(lo), "v"(hi)); return r; }
__device__ __forceinline__ float wave_sum(float v) {
#pragma unroll
    for (int o = 1; o < 64; o <<= 1) v += __shfl_xor(v, o);
    return v;
}
__device__ __forceinline__ float sigmoid_f(float x) { return __builtin_amdgcn_rcpf(1.0f + __expf(-x)); }
__device__ __forceinline__ f32x2 gelu_pk(f32x2 v) {
    const f32x2 av = __builtin_elementwise_abs(v), d = av * 0.2316418882f + 1.0f;
    f32x2 t; t.x = __builtin_amdgcn_rcpf(d.x); t.y = __builtin_amdgcn_rcpf(d.y);
    f32x2 q = t * 0.5307027145f + (-0.7265760135f); q = q * t + 0.7107068705f; q = q * t + (-0.142248368f); q = q * t + 0.127414796f; q = q * t;
    const f32x2 s = (v * v) * (-0.72134752044f);
    f32x2 e; e.x = __builtin_amdgcn_exp2f(s.x); e.y = __builtin_amdgcn_exp2f(s.y);
    const f32x2 m = v * (q * e), r = v - m;
    f32x2 o; o.x = v.x < 0.f ? m.x : r.x; o.y = v.y < 0.f ? m.y : r.y; return o;
}

#define XB_TMO      128
#define XB_XCNT(j)  (256  + 64 * (j))
#define XB_XSUB(j)  (1280 + 64 * (j))
#define XB_XGEN(j)  (2304 + 64 * (j))
#define XB_TOP      3328
#define XB_TOPGEN   3392
#define XCD_BAR_WORDS 3456
#define XB_SPIN_CAP (1u << 20)
__device__ __forceinline__ unsigned xb_ld(unsigned* p)              { return __hip_atomic_load(p, __ATOMIC_RELAXED, __HIP_MEMORY_SCOPE_AGENT); }
__device__ __forceinline__ unsigned xb_add(unsigned* p, unsigned v) { return __hip_atomic_fetch_add(p, v, __ATOMIC_RELAXED, __HIP_MEMORY_SCOPE_AGENT); }
__device__ __forceinline__ unsigned xb_xcc_id() { return (unsigned)__builtin_amdgcn_s_getreg((3 << 11) | 20) & 0xFu; }
#define XB_SPIN(cond, bar) do { unsigned _sp = 0; while (cond) { __builtin_amdgcn_s_sleep(1); \
    if ((++_sp & 255u) == 0u) { if (xb_ld(&(bar)[XB_TMO])) break; if (_sp > XB_SPIN_CAP) { atomicAdd(&(bar)[XB_TMO], 1u); break; } } } } while (0)
struct XcdBarrier { unsigned* bar; unsigned x; volatile LAS unsigned* st; };
__device__ __forceinline__ XcdBarrier xcd_barrier_post(unsigned* bar, volatile LAS unsigned* st) {
    XcdBarrier b; b.bar = bar; b.x = xb_xcc_id(); b.st = st;
    if (threadIdx.x == 0) (void)xb_add(&bar[XB_XCNT(b.x)], 1u);
    return b;
}
__device__ __forceinline__ void xcd_barrier_complete(unsigned* bar, unsigned x, unsigned& nloc, unsigned& nx) {
    const unsigned G = gridDim.x * gridDim.y * gridDim.z;
    unsigned sum, cnt, mine, sp = 0u;
    for (;;) {
        sum = 0u; cnt = 0u; mine = 0u;
#pragma unroll
        for (unsigned j = 0; j < 16; ++j) { const unsigned c = xb_ld(&bar[XB_XCNT(j)]); sum += c; cnt += (c > 0u) ? 1u : 0u; mine = (j == x) ? c : mine; }
        if (sum == G) break;
        __builtin_amdgcn_s_sleep(1);
        if ((++sp & 255u) == 0u) { if (xb_ld(&bar[XB_TMO])) break; if (sp > XB_SPIN_CAP) { atomicAdd(&bar[XB_TMO], 1u); break; } }
    }
    nloc = mine > 0u ? mine : 1u; nx = cnt > 0u ? cnt : 1u;
}
__device__ __forceinline__ void xcd_barrier(const XcdBarrier& b) {
    asm volatile("s_waitcnt vmcnt(0)" ::: "memory");
    __syncthreads();
    if (threadIdx.x == 0) {
        unsigned* bar = b.bar;
        __builtin_amdgcn_s_waitcnt(0);
        unsigned nloc = b.st[0], nx = b.st[1];
        if (nloc == 0u) { xcd_barrier_complete(bar, b.x, nloc, nx); b.st[0] = nloc; b.st[1] = nx; }
        const unsigned old = xb_add(&bar[XB_XSUB(b.x)], 1u);
        const unsigned gen = old / nloc;
        if (old + 1u == (gen + 1u) * nloc) {
            __builtin_amdgcn_fence(__ATOMIC_RELEASE, "agent");
            asm volatile("s_waitcnt vmcnt(0)" ::: "memory");
            const unsigned og = xb_add(&bar[XB_TOP], 1u);
            const unsigned tg = og / nx;
            if (og + 1u == (tg + 1u) * nx) xb_add(&bar[XB_TOPGEN], 1u);
            else XB_SPIN(xb_ld(&bar[XB_TOPGEN]) == tg, bar);
            __builtin_amdgcn_fence(__ATOMIC_ACQUIRE, "agent");
            xb_add(&bar[XB_XGEN(b.x)], 1u);
            asm volatile("s_waitcnt vmcnt(0)" ::: "memory");
        } else {
            XB_SPIN(xb_ld(&bar[XB_XGEN(b.x)]) == gen, bar);
            __builtin_amdgcn_fence(__ATOMIC_ACQUIRE, "agent");
            asm volatile("s_waitcnt vmcnt(0)" ::: "memory");
        }
    }
    __syncthreads();
}

namespace pg8 {
constexpr int BM = 256, BK = 64, HALF = 128, HTB = HALF * BK * 2, STAGE_BYTES = 8 * HTB, NXCD = 8, WGM = 8;
__device__ __forceinline__ int lds_byte(int r, int c) { const int st = (r >> 4) * 2 + (c >> 5), rr = r & 15, cc = c & 31, ob = rr * 64 + cc * 2; return st * 1024 + (ob ^ (((ob >> 9) & 1) << 5)); }
__device__ __forceinline__ void stage_rc(int b, int& R, int& C) { const int st = b / 1024, sb = b % 1024, swz = sb ^ (((sb >> 9) & 1) << 5); R = (st >> 1) * 16 + swz / 64; C = (st & 1) * 32 + (swz % 64) / 2; }
__device__ __forceinline__ int perm32(int rho) { const int n = rho >> 4, i = rho & 15; return 8 * (i >> 2) + 4 * n + (i & 3); }

struct Unit { const char* a; const char* b; int pm, pn, z, nt; };

__device__ __forceinline__ void map_tile(int L, int nM, int nN, int& pm, int& pn) {
    const int nwg = nM * nN; int wgid = L;
    { const int q = nwg / NXCD, r = nwg % NXCD, xcd = wgid % NXCD, off = wgid / NXCD; wgid = (xcd < r ? xcd * (q + 1) : r * (q + 1) + (xcd - r) * q) + off; }
    const int nig = WGM * nN, gid = wgid / nig, fm = gid * WGM, gsz = (nM - fm) < WGM ? (nM - fm) : WGM;
    pm = fm + ((wgid % nig) % gsz); pn = (wgid % nig) / gsz;
}

struct Sched {
    const char* A; const char* Bt; int lda, ldb, nN, K, ns, apn, G, c;
    __device__ __forceinline__ bool next(int i, Unit& u) const {
        const int L = i * G + c; int pm, pn, z = 0, nt;
        if (ns == 0) { if (L >= 66 * nN) return false; map_tile(L, 66, nN, pm, pn); nt = K >> 6; }
        else if (L < 64 * nN) { map_tile(L, 64, nN, pm, pn); nt = K >> 6; }
        else { const int e = L - 64 * nN; if (e >= 2 * nN * ns) return false; z = e / (2 * nN); const int r = e % (2 * nN); pm = 64 + r / nN; pn = r % nN; nt = (K / ns) >> 6; }
        const int ksub = nt * 64;
        u.a = A + ((size_t)pm * 256 * lda + (size_t)pn * apn + (size_t)z * ksub) * 2;
        u.b = Bt + ((size_t)pn * 256 * ldb + (size_t)z * ksub) * 2;
        u.pm = pm; u.pn = pn; u.z = z; u.nt = nt; return true;
    }
};

struct EpiF32 {
    static constexpr bool PERM = false;
    float* C; float* FX; int ldc; int act; const float* scale;
    __device__ __forceinline__ void operator()(const f32x4 (&acc)[2][2][4][2], const Unit& u, int wr, int wc, int fr, int fq) const {
        const int row0 = u.pm * BM + wr * 64 + fr, col0 = u.pn * BM + wc * 32 + 4 * fq;
        float* base = (u.z == 0) ? C + (size_t)row0 * ldc : FX + ((size_t)(u.z - 1) * TS + (row0 - TP)) * ldc;
        f32x4 sv[2][2];
#pragma unroll
        for (int bj = 0; bj < 2; ++bj)
#pragma unroll
            for (int n = 0; n < 2; ++n) sv[bj][n] = scale ? *(const f32x4*)(scale + col0 + bj * HALF + n * 16) : (f32x4){1.f, 1.f, 1.f, 1.f};
#pragma unroll
        for (int ai = 0; ai < 2; ++ai)
#pragma unroll
            for (int m = 0; m < 4; ++m) { float* rowp = base + (size_t)(ai * HALF + m * 16) * ldc + col0;
#pragma unroll
                for (int bj = 0; bj < 2; ++bj)
#pragma unroll
                    for (int n = 0; n < 2; ++n) { f32x4 v = acc[ai][bj][m][n];
                        if (act) { const f32x2 a = gelu_pk((f32x2){v[0], v[1]}), b = gelu_pk((f32x2){v[2], v[3]}); v = (f32x4){a.x, a.y, b.x, b.y}; }
                        *(f32x4*)(rowp + bj * HALF + n * 16) = v * sv[bj][n]; } }
    }
};
struct EpiGated {
    static constexpr bool PERM = true;
    bf16_t* O; float* OF; int ldo; int mode;
    __device__ __forceinline__ void operator()(const f32x4 (&acc)[2][2][4][2], const Unit& u, int wr, int wc, int fr, int fq) const {
        const int row0 = u.pm * BM + wr * 64 + fr, col0 = u.pn * HALF + wc * 32 + 8 * fq;
#pragma unroll
        for (int ai = 0; ai < 2; ++ai)
#pragma unroll
            for (int m = 0; m < 4; ++m) { const size_t off = (size_t)(row0 + ai * HALF + m * 16) * ldo + col0;
                f32x4 r[2];
#pragma unroll
                for (int n = 0; n < 2; ++n) { const f32x4 p = acc[ai][0][m][n], q = acc[ai][1][m][n];
#pragma unroll
                    for (int j = 0; j < 4; ++j) r[n][j] = (mode == 0) ? p[j] * sigmoid_f(p[j]) * q[j] : (mode == 1 ? p[j] * sigmoid_f(q[j]) : p[j] * q[j]); }
                if (mode == 0) { u32x4 w; w.x = cvt_pk_bf16(r[0][0], r[0][1]); w.y = cvt_pk_bf16(r[0][2], r[0][3]); w.z = cvt_pk_bf16(r[1][0], r[1][1]); w.w = cvt_pk_bf16(r[1][2], r[1][3]); *(u32x4*)(O + off) = w; }
                else { *(f32x4*)(OF + off) = r[0]; *(f32x4*)(OF + off + 4) = r[1]; } }
    }
};

template <class Epi>
__device__ __forceinline__ void gemm_phase(LAS unsigned char* lds, const Sched& S, const Epi& E) {
    const int tid = threadIdx.x, wid = __builtin_amdgcn_readfirstlane(tid >> 6), lane = tid & 63, wr = wid >> 2, wc = wid & 3, fr = lane & 15, fq = lane >> 4;
    const int lda = S.lda, ldb = S.ldb;
    unsigned voffA[2], voffB[2];
#pragma unroll
    for (int i = 0; i < 2; ++i) { int R, C; stage_rc(tid * 16 + i * 8192, R, C); const int Rb = Epi::PERM ? ((R & ~31) + perm32(R & 31)) : R;
        voffA[i] = (unsigned)(R * lda + C) * 2u; voffB[i] = (unsigned)(Rb * ldb + C) * 2u; }
    const size_t kstep = (size_t)(BK * 2);
    const size_t hstepA = (size_t)HALF * lda * 2, hstepB = (size_t)HALF * ldb * 2;
    const unsigned ldsw = (unsigned)wid * 1024u;
    const int aoff = lds_byte(wr * 64 + fr, fq * 8), boff = lds_byte(wc * 32 + fr, fq * 8);
#define PG8_SA(b, h) (((b) * 2 + (h)) * HTB)
#define PG8_SB(b, h) ((4 + (b) * 2 + (h)) * HTB)
#define PG8_STAGE(bufoff, gbase, voff) do { _Pragma("unroll") for (int _i = 0; _i < 2; ++_i) \
        __builtin_amdgcn_global_load_lds((const unsigned*)((const char*)(gbase) + (voff)[_i]), (LAS unsigned*)(lds + (bufoff) + ldsw + _i * 8192), 16, 0, 0); } while (0)
#define PG8_LDA(dst, b, h) do { _Pragma("unroll") for (int m = 0; m < 4; ++m) _Pragma("unroll") for (int k = 0; k < 2; ++k) dst[m][k] = *(const LAS bf16x8*)(lds + PG8_SA(b, h) + aoff + m * 2048 + k * 1024); } while (0)
#define PG8_LDB(dst, b, h) do { _Pragma("unroll") for (int n = 0; n < 2; ++n) _Pragma("unroll") for (int k = 0; k < 2; ++k) dst[n][k] = *(const LAS bf16x8*)(lds + PG8_SB(b, h) + boff + n * 2048 + k * 1024); } while (0)
#define PG8_MMA(ai, bj, At, Bt) do { __builtin_amdgcn_s_setprio(1); _Pragma("unroll") for (int m = 0; m < 4; ++m) _Pragma("unroll") for (int n = 0; n < 2; ++n) _Pragma("unroll") for (int k = 0; k < 2; ++k) \
        acc[ai][bj][m][n] = __builtin_amdgcn_mfma_f32_16x16x32_bf16(Bt[n][k], At[m][k], acc[ai][bj][m][n], 0, 0, 0); __builtin_amdgcn_s_setprio(0); } while (0)
#define PG8_WAIT_V(n) asm volatile("s_waitcnt vmcnt(" #n ")" ::: "memory")
#define PG8_WAIT_L(n) asm volatile("s_waitcnt lgkmcnt(" #n ")" ::: "memory")
#define PG8_BAR __builtin_amdgcn_s_barrier()
#define PG8_SCHED __builtin_amdgcn_sched_barrier(0)
    Unit cur, nxt; int ui = 0;
    if (!S.next(0, cur)) return;
    f32x4 acc[2][2][4][2];
#pragma unroll
    for (int a = 0; a < 2; ++a)
#pragma unroll
        for (int b = 0; b < 2; ++b)
#pragma unroll
            for (int m = 0; m < 4; ++m)
#pragma unroll
                for (int n = 0; n < 2; ++n) acc[a][b][m][n] = (f32x4){0.f, 0.f, 0.f, 0.f};
    bf16x8 At[4][2], B0[2][2], B1[2][2];
    const char* cA = cur.a; const char* cB = cur.b;
    PG8_STAGE(PG8_SB(0, 0), cB, voffB); PG8_STAGE(PG8_SB(0, 1), cB + hstepB, voffB); PG8_STAGE(PG8_SA(0, 0), cA, voffA); PG8_STAGE(PG8_SA(0, 1), cA + hstepA, voffA);
    if (wr == 1) PG8_BAR;
    PG8_WAIT_V(2); PG8_BAR;
    PG8_STAGE(PG8_SB(1, 0), cB + kstep, voffB); PG8_STAGE(PG8_SA(1, 0), cA + kstep, voffA); PG8_STAGE(PG8_SB(1, 1), cB + hstepB + kstep, voffB);
    PG8_WAIT_V(6); PG8_BAR;
    for (;;) {
        const bool has_next = S.next(ui + 1, nxt);
        const char* nA = has_next ? nxt.a : cA; const char* nB = has_next ? nxt.b : cB;
        const int nt = cur.nt;
        for (int t = 0; t < nt; t += 2) {
            const bool last = (t == nt - 2);
            const char* a1 = cA + (size_t)(t + 1) * kstep;
            const char* a2 = last ? nA : cA + (size_t)(t + 2) * kstep; const char* b2 = last ? nB : cB + (size_t)(t + 2) * kstep;
            const char* a3 = a2 + kstep; const char* b3 = b2 + kstep;
            PG8_LDB(B0, 0, 0); PG8_LDB(B1, 0, 1); PG8_SCHED; PG8_LDA(At, 0, 0); PG8_STAGE(PG8_SA(1, 1), a1 + hstepA, voffA);
            PG8_WAIT_V(8); PG8_WAIT_L(0); PG8_BAR; PG8_MMA(0, 0, At, B0); PG8_MMA(0, 1, At, B1); PG8_BAR; PG8_SCHED;
            PG8_LDA(At, 0, 1); PG8_STAGE(PG8_SB(0, 0), b2, voffB); PG8_STAGE(PG8_SB(0, 1), b2 + hstepB, voffB); PG8_STAGE(PG8_SA(0, 0), a2, voffA);
            PG8_WAIT_V(8); PG8_WAIT_L(0); PG8_BAR; PG8_MMA(1, 0, At, B0); PG8_MMA(1, 1, At, B1); PG8_BAR; PG8_SCHED;
            PG8_LDB(B0, 1, 0); PG8_LDB(B1, 1, 1); PG8_SCHED; PG8_LDA(At, 1, 0); PG8_STAGE(PG8_SA(0, 1), a2 + hstepA, voffA);
            PG8_WAIT_V(8); PG8_WAIT_L(0); PG8_BAR; PG8_MMA(0, 0, At, B0); PG8_MMA(0, 1, At, B1); PG8_BAR; PG8_SCHED;
            PG8_LDA(At, 1, 1); PG8_STAGE(PG8_SB(1, 0), b3, voffB); PG8_STAGE(PG8_SB(1, 1), b3 + hstepB, voffB); PG8_STAGE(PG8_SA(1, 0), a3, voffA);
            PG8_WAIT_V(8); PG8_WAIT_L(0); PG8_BAR; PG8_MMA(1, 0, At, B0); PG8_MMA(1, 1, At, B1); PG8_BAR; PG8_SCHED;
        }
        if (wr == 0) PG8_BAR;
        E(acc, cur, wr, wc, fr, fq);
        if (!has_next) break;
#pragma unroll
        for (int a = 0; a < 2; ++a)
#pragma unroll
            for (int b = 0; b < 2; ++b)
#pragma unroll
                for (int m = 0; m < 4; ++m)
#pragma unroll
                    for (int n = 0; n < 2; ++n) acc[a][b][m][n] = (f32x4){0.f, 0.f, 0.f, 0.f};
        cur = nxt; cA = nA; cB = nB; ++ui;
        if (wr == 1) PG8_BAR;
    }
    PG8_WAIT_V(0);
    PG8_BAR;
#undef PG8_SA
#undef PG8_SB
#undef PG8_STAGE
#undef PG8_LDA
#undef PG8_LDB
#undef PG8_MMA
#undef PG8_WAIT_V
#undef PG8_WAIT_L
#undef PG8_BAR
#undef PG8_SCHED
}
}

#define LDS_WAIT() asm volatile("s_waitcnt lgkmcnt(0)" ::: "memory")
__device__ __forceinline__ void transpose_item(const float* W, int N, bf16_t* WT, int K, int k0, int n0, int r0, LAS float* scr, int lane) {
#pragma unroll 8
    for (int i = 0; i < 32; ++i) { const int kk = 2 * i + (lane >> 5); scr[kk * 33 + (lane & 31)] = W[(size_t)(k0 + kk) * N + n0 + (lane & 31)]; }
    LDS_WAIT();
    const int c = lane & 7;
#pragma unroll
    for (int j = 0; j < 4; ++j) { const int n = (lane >> 3) + 8 * j; const LAS float* s = scr + (8 * c) * 33 + n;
        u32x4 o; o.x = cvt_pk_bf16(s[0 * 33], s[1 * 33]); o.y = cvt_pk_bf16(s[2 * 33], s[3 * 33]); o.z = cvt_pk_bf16(s[4 * 33], s[5 * 33]); o.w = cvt_pk_bf16(s[6 * 33], s[7 * 33]);
        *(u32x4*)(WT + (size_t)(r0 + n) * K + k0 + 8 * c) = o; }
    LDS_WAIT();
}
__device__ __forceinline__ void convert_matrix(const float* W, int K, int N, int half, bf16_t* WT, int item, LAS float* scr, int lane) {
    const int nblk = N / 32, kb = item / nblk, nb = item % nblk, r0 = nb * 32;
    const int n0 = half ? (((r0 >> 7) & 1) * half + (r0 >> 8) * 128 + (r0 & 127)) : r0;
    transpose_item(W, N, WT, K, kb * 64, n0, r0, scr, lane);
}

__device__ __forceinline__ void phase_prologue(KP p, LAS unsigned char* lds, int gw, int ngw, int wave, int lane) {
    LAS float* scr = (LAS float*)(lds + wave * 16384);
    unsigned char* ws = p->ws;
    constexpr int I_FIN = 16 * 176, I_FDN = 44 * 32, I_AIN = 16 * 64, I_SQ = 16 * 32, I_BIN = 16 * 96, I_D = 4 * 8;
    constexpr int NITEMS = 8 * I_FIN + 8 * I_FDN + I_AIN + I_SQ + I_BIN + I_SQ + I_AIN + I_SQ + 4 * I_D;
    for (int it = gw; it < NITEMS; it += ngw) {
        int r = it;
        if (r < 8 * I_FIN) { const int m = r / I_FIN; convert_matrix(p->in[6] + (size_t)m * DM * 2 * DFF, DM, 2 * DFF, DFF, (bf16_t*)(ws + WS_W_FFN_IN + m * SZ_FFN_IN), r % I_FIN, scr, lane); continue; } r -= 8 * I_FIN;
        if (r < 8 * I_FDN) { const int m = r / I_FDN; convert_matrix(p->in[7] + (size_t)m * DFF * DM, DFF, DM, 0, (bf16_t*)(ws + WS_W_FFN_DN + m * SZ_FFN_DN), r % I_FDN, scr, lane); continue; } r -= 8 * I_FDN;
        if (r < I_AIN) { convert_matrix(p->in[8], DM, 2048, 1024, (bf16_t*)(ws + WS_W_A_IN), r, scr, lane); continue; } r -= I_AIN;
        if (r < I_SQ) { convert_matrix(p->in[13], DM, DM, 0, (bf16_t*)(ws + WS_W_A_OUT), r, scr, lane); continue; } r -= I_SQ;
        if (r < I_BIN) {
            const int nblk = 96, kb = r / nblk, nb = r % nblk, r0 = nb * 32;
            const int n0 = (r0 < 2048) ? (1024 + ((r0 >> 7) & 1) * 1024 + (r0 >> 8) * 128 + (r0 & 127)) : (r0 - 2048);
            transpose_item(p->in[14], 3072, (bf16_t*)(ws + WS_W_B_IN), DM, kb * 64, n0, r0, scr, lane); continue; } r -= I_BIN;
        if (r < I_SQ) { convert_matrix(p->in[16], DM, DM, 0, (bf16_t*)(ws + WS_W_B_OUT), r, scr, lane); continue; } r -= I_SQ;
        if (r < I_AIN) { convert_matrix(p->in[17], DM, 2048, 0, (bf16_t*)(ws + WS_W_C_IN), r, scr, lane); continue; } r -= I_AIN;
        if (r < I_SQ) { convert_matrix(p->in[22], DM, DM, 0, (bf16_t*)(ws + WS_W_C_OUT), r, scr, lane); continue; } r -= I_SQ;
        { const int g = r / I_D; convert_matrix(p->in[23] + (size_t)g * 65536, 256, 256, 0, (bf16_t*)(ws + WS_W_D) + (size_t)g * 65536, r % I_D, scr, lane); }
    }
    float* h = p->out + O_Y; bf16_t* hb = (bf16_t*)(ws + WS_HB); const float* g0 = p->in[5];
    for (int t = gw; t < NTOK; t += ngw) {
        const float* src = (t < TP) ? p->in[0] + (size_t)t * DM : p->in[1] + (size_t)(t - TP) * DM;
        const f32x4* xr = (const f32x4*)src + lane; f32x4 v[4]; float ss = 0.f;
#pragma unroll
        for (int j = 0; j < 4; ++j) { v[j] = xr[64 * j]; ss += (v[j].x * v[j].x + v[j].y * v[j].y) + (v[j].z * v[j].z + v[j].w * v[j].w); }
        const float rs = 1.0f / sqrtf(wave_sum(ss) * (1.0f / DM) + EPS);
        f32x4* hr = (f32x4*)(h + (size_t)t * DM) + lane; u32x2* ob = (u32x2*)(hb + (size_t)t * DM) + lane;
#pragma unroll
        for (int j = 0; j < 4; ++j) { hr[64 * j] = v[j]; const f32x4 g = ((const f32x4*)g0)[lane + 64 * j]; const f32x4 x = v[j] * rs * g;
            u32x2 w; w.x = cvt_pk_bf16(x.x, x.y); w.y = cvt_pk_bf16(x.z, x.w); ob[64 * j] = w; }
    }
}

__device__ __forceinline__ void phase_resnorm(float* h, const float* F, const float* FX, int ns, float scale, const float* gA, const float* gB,
                                              bf16_t* hb, float* xmf, int mode, int gw, int ngw, int lane) {
    for (int t = gw; t < NTOK; t += ngw) {
        const f32x4* fr = (const f32x4*)(F + (size_t)t * DM) + lane; f32x4 f[4];
#pragma unroll
        for (int j = 0; j < 4; ++j) f[j] = fr[64 * j];
        if (t >= TP) for (int z = 1; z < ns; ++z) { const f32x4* xr = (const f32x4*)(FX + ((size_t)(z - 1) * TS + (t - TP)) * DM) + lane;
#pragma unroll
            for (int j = 0; j < 4; ++j) f[j] += xr[64 * j]; }
        float ss = 0.f;
#pragma unroll
        for (int j = 0; j < 4; ++j) ss += (f[j].x * f[j].x + f[j].y * f[j].y) + (f[j].z * f[j].z + f[j].w * f[j].w);
        const float rs = scale / sqrtf(wave_sum(ss) * (1.0f / DM) + EPS);
        f32x4* hr = (f32x4*)(h + (size_t)t * DM) + lane; f32x4 hv[4]; float s2 = 0.f;
#pragma unroll
        for (int j = 0; j < 4; ++j) { const f32x4 g = ((const f32x4*)gA)[lane + 64 * j]; hv[j] = hr[64 * j] + f[j] * rs * g; hr[64 * j] = hv[j];
            s2 += (hv[j].x * hv[j].x + hv[j].y * hv[j].y) + (hv[j].z * hv[j].z + hv[j].w * hv[j].w); }
        if (mode != 2) {
            const float r2 = 1.0f / sqrtf(wave_sum(s2) * (1.0f / DM) + EPS);
            u32x2* ob = (u32x2*)(hb + (size_t)t * DM) + lane;
#pragma unroll
            for (int j = 0; j < 4; ++j) { const f32x4 g = ((const f32x4*)gB)[lane + 64 * j]; const f32x4 x = hv[j] * r2 * g;
                u32x2 w; w.x = cvt_pk_bf16(x.x, x.y); w.y = cvt_pk_bf16(x.z, x.w); ob[64 * j] = w;
                if (mode == 1) ((f32x4*)(xmf + (size_t)t * DM) + lane)[64 * j] = x; }
        }
    }
}

__device__ __forceinline__ void phase_conv(KP p, const float* glu, bf16_t* yb, LAS unsigned char* lds, int c, int G, int wave, int lane) {
    const float* state_a = p->in[2]; const float* cw = p->in[9]; const float* cbias = p->in[10]; const float* lg = p->in[11]; const float* lb = p->in[12];
    LAS float* buf = (LAS float*)lds;
    const int ch = wave * 128 + lane * 2;
    f32x2 w[31];
#pragma unroll
    for (int j = 0; j < 31; ++j) w[j] = *(const f32x2*)(cw + j * DM + ch);
    const f32x2 bias = *(const f32x2*)(cbias + ch);
    for (int gp = c; gp < NTOK / 8; gp += G) {
#pragma unroll 1
        for (int gsel = 0; gsel < 2; ++gsel) {
            const int t0 = 8 * gp + 4 * gsel; const bool samp = t0 >= TP;
            const int b = samp ? ((t0 - TP) >> 2) : (t0 >> 11), s0 = samp ? 0 : (t0 & 2047);
            f32x2 acc[4] = {bias, bias, bias, bias};
#pragma unroll
            for (int r = 0; r < 34; ++r) {
                const int rel = r - 30;
                const float* ptr; float fac = 1.0f;
                if (rel >= 0) ptr = glu + (size_t)(t0 + rel) * DM;
                else if (samp) ptr = state_a + ((size_t)b * 30 + 30 + rel) * DM;
                else { const bool ok = (s0 + rel >= 0); ptr = glu + (size_t)(ok ? t0 + rel : t0) * DM; fac = ok ? 1.0f : 0.0f; }
                f32x2 x = *(const f32x2*)(ptr + ch); if (rel < 0) x = x * fac;
#pragma unroll
                for (int o = 0; o < 4; ++o) { const int j = r - o; if (j >= 0 && j <= 30) acc[o] += w[j] * x; }
            }
#pragma unroll
            for (int o = 0; o < 4; ++o) *(LAS f32x2*)(buf + (gsel * 4 + o) * DM + ch) = acc[o];
        }
        __syncthreads();
        {
            const int t = 8 * gp + wave; const LAS f32x4* br = (const LAS f32x4*)(buf + wave * DM) + lane; f32x4 v[4]; float s = 0.f;
#pragma unroll
            for (int j = 0; j < 4; ++j) { v[j] = br[64 * j]; s += (v[j].x + v[j].y) + (v[j].z + v[j].w); }
            const float mean = wave_sum(s) * (1.0f / DM); float s2 = 0.f;
#pragma unroll
            for (int j = 0; j < 4; ++j) { v[j] = v[j] - mean; s2 += (v[j].x * v[j].x + v[j].y * v[j].y) + (v[j].z * v[j].z + v[j].w * v[j].w); }
            const float rstd = 1.0f / sqrtf(wave_sum(s2) * (1.0f / DM) + EPS);
            u32x2* ob = (u32x2*)(yb + (size_t)t * DM) + lane;
#pragma unroll
            for (int j = 0; j < 4; ++j) { const f32x4 g = ((const f32x4*)lg)[lane + 64 * j], bb = ((const f32x4*)lb)[lane + 64 * j]; f32x4 y = v[j] * rstd * g + bb;
#pragma unroll
                for (int e = 0; e < 4; ++e) y[e] = y[e] * sigmoid_f(y[e]);
                u32x2 o; o.x = cvt_pk_bf16(y.x, y.y); o.y = cvt_pk_bf16(y.z, y.w); ob[64 * j] = o; }
        }
        __syncthreads();
    }
    const int gw = c * NWAVES + wave, ngw = G * NWAVES;
    for (int it = gw; it < (8 + 128) * 30; it += ngw) {
        const float* src; float* dst;
        if (it < 240) { const int b = it / 30, r = it % 30; src = glu + ((size_t)b * 2048 + 2018 + r) * DM; dst = p->out + O_SA_P + (size_t)it * DM; }
        else { const int e = it - 240, b = e / 30, r = e % 30; src = (r < 26) ? state_a + ((size_t)b * 30 + r + 4) * DM : glu + ((size_t)TP + b * 4 + r - 26) * DM; dst = p->out + O_SA_S + (size_t)e * DM; }
#pragma unroll
        for (int j = 0; j < 4; ++j) ((f32x4*)dst + lane)[64 * j] = ((const f32x4*)src + lane)[64 * j];
    }
}

__device__ __forceinline__ void phase_gate(KP p, const float* z, const float* bg, bf16_t* yb, int gw, int ngw, int lane) {
    const float* state_b = p->in[3]; const float* cw = p->in[15];
    for (int t = gw; t < NTOK; t += ngw) {
        const bool samp = t >= TP; const int b = samp ? ((t - TP) >> 2) : (t >> 11), s = samp ? ((t - TP) & 3) : (t & 2047);
        const float* r2 = z + (size_t)t * DM;
        const float* r1; const float* r0; float f1 = 1.f, f0 = 1.f;
        if (s >= 1) r1 = z + (size_t)(t - 1) * DM; else if (samp) r1 = state_b + ((size_t)b * 2 + 1) * DM; else { r1 = r2; f1 = 0.f; }
        if (s >= 2) r0 = z + (size_t)(t - 2) * DM; else if (samp) r0 = state_b + ((size_t)b * 2 + s) * DM; else { r0 = r2; f0 = 0.f; }
        u32x2* ob = (u32x2*)(yb + (size_t)t * DM) + lane;
        float* st = nullptr;
        if (!samp && s >= 2046) st = p->out + O_SB_P + ((size_t)b * 2 + (s - 2046)) * DM;
        if (samp && s >= 2) st = p->out + O_SB_S + ((size_t)b * 2 + (s - 2)) * DM;
#pragma unroll
        for (int j = 0; j < 4; ++j) {
            const f32x4 z2 = ((const f32x4*)r2 + lane)[64 * j], z1 = ((const f32x4*)r1 + lane)[64 * j] * f1, z0 = ((const f32x4*)r0 + lane)[64 * j] * f0;
            const f32x4 w0 = ((const f32x4*)cw + lane)[64 * j], w1 = ((const f32x4*)(cw + DM) + lane)[64 * j], w2 = ((const f32x4*)(cw + 2 * DM) + lane)[64 * j];
            const f32x4 g = ((const f32x4*)(bg + (size_t)t * DM) + lane)[64 * j];
            const f32x4 y = g * (w0 * z0 + w1 * z1 + w2 * z2);
            u32x2 o; o.x = cvt_pk_bf16(y.x, y.y); o.y = cvt_pk_bf16(y.z, y.w); ob[64 * j] = o;
            if (st) ((f32x4*)st + lane)[64 * j] = z2;
        }
    }
}

__device__ __forceinline__ void phase_vln(KP p, const float* zz, bf16_t* vn, int gw, int ngw, int lane) {
    const float* lg = p->in[18]; const float* lb = p->in[19];
    for (int t = gw; t < NTOK; t += ngw) {
        const f32x4* vr = (const f32x4*)(zz + (size_t)t * 2048 + 1024) + lane; f32x4 v[4]; float s = 0.f;
#pragma unroll
        for (int j = 0; j < 4; ++j) { v[j] = vr[64 * j]; s += (v[j].x + v[j].y) + (v[j].z + v[j].w); }
        const float mean = wave_sum(s) * (1.0f / DM); float s2 = 0.f;
#pragma unroll
        for (int j = 0; j < 4; ++j) { v[j] = v[j] - mean; s2 += (v[j].x * v[j].x + v[j].y * v[j].y) + (v[j].z * v[j].z + v[j].w * v[j].w); }
        const float rstd = 1.0f / sqrtf(wave_sum(s2) * (1.0f / DM) + EPS);
        u32x2* ob = (u32x2*)(vn + (size_t)t * DM) + lane;
#pragma unroll
        for (int j = 0; j < 4; ++j) { const f32x4 g = ((const f32x4*)lg)[lane + 64 * j], bb = ((const f32x4*)lb)[lane + 64 * j]; const f32x4 y = v[j] * rstd * g + bb;
            u32x2 o; o.x = cvt_pk_bf16(y.x, y.y); o.y = cvt_pk_bf16(y.z, y.w); ob[64 * j] = o;
            if (t >= TP) ((f32x4*)(p->out + O_SC_S + (size_t)(t - TP) * DM) + lane)[64 * j] = y; }
    }
}

__device__ __forceinline__ void phase_spatial(KP p, const float* zz, const bf16_t* vn, bf16_t* yb, LAS unsigned char* lds, int c, int G, int tid, int wave, int lane) {
    const float* wsp = p->in[20]; const float* bsp = p->in[21];
    constexpr int LD = 136;
    LAS bf16_t* WmL = (LAS bf16_t*)lds; LAS bf16_t* VT = (LAS bf16_t*)(lds + 128 * LD * 2);
    for (int u = c; u < 132 * 8; u += G) {
        const int h = u & 7, cu = u >> 3; const bool samp = cu >= 128; const int tok0 = samp ? TP + (cu - 128) * 128 : cu * 128;
        for (int k = 0; k < 16; ++k) { const int idx = tid + 512 * k, i = idx >> 6, j2 = (idx & 63) * 2;
            float w0, w1;
            if (!samp) { const f32x2 ww = *(const f32x2*)(wsp + (size_t)h * 16384 + i * 128 + j2); w0 = (j2 <= i) ? ww.x : 0.f; w1 = (j2 + 1 <= i) ? ww.y : 0.f; }
            else { const bool same = (i >> 2) == (j2 >> 2); const int ti = i & 3, tj = j2 & 3; const f32x2 ww = *(const f32x2*)(wsp + (size_t)h * 16384 + ti * 128 + tj);
                   w0 = (same && tj <= ti) ? ww.x : 0.f; w1 = (same && tj + 1 <= ti) ? ww.y : 0.f; }
            *(LAS unsigned*)(WmL + i * LD + j2) = cvt_pk_bf16(w0, w1); }
#pragma unroll
        for (int k = 0; k < 4; ++k) { const int idx = tid + 512 * k, j = idx >> 4, cp = idx & 15;
            const u32x4 v = *(const u32x4*)(vn + (size_t)(tok0 + j) * DM + h * 128 + cp * 8);
            LAS bf16_t* d = VT + (cp * 8) * LD + j;
            d[0 * LD] = (bf16_t)(v.x & 0xffff); d[1 * LD] = (bf16_t)(v.x >> 16); d[2 * LD] = (bf16_t)(v.y & 0xffff); d[3 * LD] = (bf16_t)(v.y >> 16);
            d[4 * LD] = (bf16_t)(v.z & 0xffff); d[5 * LD] = (bf16_t)(v.z >> 16); d[6 * LD] = (bf16_t)(v.w & 0xffff); d[7 * LD] = (bf16_t)(v.w >> 16); }
        __syncthreads();
        const int i0 = 16 * wave, fr = lane & 15, fq = lane >> 4;
        f32x4 acc[8];
#pragma unroll
        for (int cb = 0; cb < 8; ++cb) acc[cb] = (f32x4){0.f, 0.f, 0.f, 0.f};
        const int nks = (i0 + 15) / 32 + 1;
        for (int ks = 0; ks < nks; ++ks) {
            const bf16x8 wf = *(const LAS bf16x8*)(WmL + (i0 + fr) * LD + ks * 32 + 8 * fq);
#pragma unroll
            for (int cb = 0; cb < 8; ++cb) { const bf16x8 vf = *(const LAS bf16x8*)(VT + (cb * 16 + fr) * LD + ks * 32 + 8 * fq);
                acc[cb] = __builtin_amdgcn_mfma_f32_16x16x32_bf16(vf, wf, acc[cb], 0, 0, 0); }
        }
        const int i = i0 + fr, tok = tok0 + i; const float bsv = bsp[h * 128 + (samp ? (i & 3) : i)];
#pragma unroll
        for (int cb = 0; cb < 8; ++cb) { const int col = h * 128 + cb * 16 + fq * 4;
            const f32x4 uu = *(const f32x4*)(zz + (size_t)tok * 2048 + col); const f32x4 y = uu * (acc[cb] + bsv);
            u32x2 o; o.x = cvt_pk_bf16(y.x, y.y); o.y = cvt_pk_bf16(y.z, y.w); *(u32x2*)(yb + (size_t)tok * DM + col) = o; }
        __syncthreads();
    }
}

__device__ __forceinline__ void phase_pool(KP p, const float* xm, bf16_t* yb, int gw, int ngw, int lane) {
    const float* state_p = p->in[4];
    for (int t = gw; t < NTOK; t += ngw) {
        const bool samp = t >= TP; const int b = samp ? ((t - TP) >> 2) : (t >> 11), s = samp ? ((t - TP) & 3) : (t & 2047);
        u32x2* ob = (u32x2*)(yb + (size_t)t * DM) + lane;
#pragma unroll
        for (int j = 0; j < 4; ++j) {
            const int w = 2 << j; const f32x4 x0 = ((const f32x4*)(xm + (size_t)t * DM) + lane)[64 * j]; f32x4 sum = x0;
#pragma unroll
            for (int d = 1; d < w; ++d) {
                const float* ptr; float fac = 1.f;
                if (s - d >= 0) ptr = xm + (size_t)(t - d) * DM; else if (samp) ptr = state_p + ((size_t)b * 15 + 15 + (s - d)) * DM; else { ptr = xm + (size_t)t * DM; fac = 0.f; }
                sum += ((const f32x4*)ptr + lane)[64 * j] * fac;
            }
            const float cnt = samp ? (float)w : (float)((s + 1 < w) ? s + 1 : w);
            const f32x4 y = sum * (1.0f / cnt) - x0;
            u32x2 o; o.x = cvt_pk_bf16(y.x, y.y); o.y = cvt_pk_bf16(y.z, y.w); ob[64 * j] = o;
        }
    }
    for (int it = gw; it < (8 + 128) * 15; it += ngw) {
        const float* src; float* dst;
        if (it < 120) { const int b = it / 15, r = it % 15; src = xm + ((size_t)b * 2048 + 2033 + r) * DM; dst = p->out + O_SP_P + (size_t)it * DM; }
        else { const int e = it - 120, b = e / 15, r = e % 15; src = (r < 11) ? state_p + ((size_t)b * 15 + r + 4) * DM : xm + ((size_t)TP + b * 4 + r - 11) * DM; dst = p->out + O_SP_S + (size_t)e * DM; }
#pragma unroll
        for (int j = 0; j < 4; ++j) ((f32x4*)dst + lane)[64 * j] = ((const f32x4*)src + lane)[64 * j];
    }
}

__global__ void __launch_bounds__(NTHREADS, 2) mega_fwd(Params p_unused) {
    extern __shared__ __attribute__((aligned(16))) unsigned char shm[];
    LAS unsigned char* lds = (LAS unsigned char*)shm;
    cg::grid_group grid = cg::this_grid();
    volatile LAS unsigned* st = (volatile LAS unsigned*)(lds + 131072);
    if (threadIdx.x == 0) { st[0] = 0u; st[1] = 0u; st[2] = 0u; st[3] = 0u; }
    __syncthreads();
    XcdBarrier bar;
    {
        KP p = (KP)__builtin_amdgcn_kernarg_segment_ptr();
        const int tid = threadIdx.x, lane = tid & 63, wave = __builtin_amdgcn_readfirstlane(tid >> 6);
        const int G = gridDim.x, c = blockIdx.x, gw = c * NWAVES + wave, ngw = G * NWAVES;
        bar = xcd_barrier_post((unsigned*)(p->ws + WS_BAR), st);
        phase_prologue(p, lds, gw, ngw, wave, lane);
    }
    grid.sync();

#pragma unroll 1
    for (int ph = 0; ph < NLAYER * 11; ++ph) {
        KP p = (KP)__builtin_amdgcn_kernarg_segment_ptr(); asm volatile("" : "+s"(p));
        int tid = threadIdx.x; asm volatile("" : "+v"(tid));
        int G = gridDim.x, c = blockIdx.x; asm volatile("" : "+s"(G), "+s"(c));
        const int lane = tid & 63, wave = __builtin_amdgcn_readfirstlane(tid >> 6), gw = c * NWAVES + wave, ngw = G * NWAVES;
        unsigned char* ws = p->ws;
        const int layer = ph / 11, step = ph % 11;
        float* h = p->out + O_Y;
        bf16_t* hb = (bf16_t*)(ws + WS_HB);
        bf16_t* act = (bf16_t*)(ws + WS_ACT);
        bf16_t* yb = (bf16_t*)(ws + WS_ACT);
        bf16_t* vn = (bf16_t*)(ws + WS_ACT + (size_t)NTOK * DM * 2);
        float* F = (float*)(ws + WS_F);
        float* FX = (float*)(ws + WS_FX);
        float* MT = (float*)(ws + WS_MT);
        const float* g6 = p->in[5] + (size_t)layer * 6 * DM;
        int kind;
        switch (step) {
            case 0: case 8: kind = 1; break;
            case 1: case 9: case 6: kind = 2; break;
            case 2: case 7: case 10: kind = 3; break;
            case 3: kind = (layer == 0 || layer == 1) ? 1 : (layer == 2 ? 2 : 8); break;
            case 4: kind = (layer == 0) ? 4 : (layer == 1 ? 2 : (layer == 2 ? 6 : 0)); break;
            default: kind = (layer == 1) ? 5 : (layer == 2 ? 7 : 0); break;
        }
        if (kind == 0) continue;
        if (kind == 1) {
            pg8::Sched S; S.A = (const char*)hb; S.lda = DM; S.ldb = DM; S.K = DM; S.ns = 0; S.apn = 0; S.G = G; S.c = c;
            pg8::EpiGated E;
            if (step != 3) { S.Bt = (const char*)(ws + WS_W_FFN_IN + (size_t)(layer * 2 + (step == 8 ? 1 : 0)) * SZ_FFN_IN); S.nN = 22; E.O = act; E.OF = nullptr; E.ldo = DFF; E.mode = 0; }
            else { S.Bt = (const char*)(ws + (layer == 0 ? WS_W_A_IN : WS_W_B_IN)); S.nN = 8; E.O = nullptr; E.OF = MT; E.ldo = DM; E.mode = (layer == 0) ? 1 : 2; }
            pg8::gemm_phase(lds, S, E);
        } else if (kind == 2) {
            pg8::Sched S; S.G = G; S.c = c; S.apn = 0; S.ns = 0;
            pg8::EpiF32 E; E.FX = FX; E.ldc = DM; E.act = 0; E.scale = nullptr;
            if (step == 1 || step == 9) { S.A = (const char*)act; S.Bt = (const char*)(ws + WS_W_FFN_DN + (size_t)(layer * 2 + (step == 9 ? 1 : 0)) * SZ_FFN_DN); S.lda = DFF; S.ldb = DFF; S.nN = 4; S.K = DFF; S.ns = 11; E.C = F; }
            else if (step == 3) { S.A = (const char*)hb; S.Bt = (const char*)(ws + WS_W_C_IN); S.lda = DM; S.ldb = DM; S.nN = 8; S.K = DM; E.C = MT; E.ldc = 2048; E.act = 1; }
            else if (step == 4) { S.A = (const char*)hb; S.Bt = (const char*)(ws + WS_W_B_IN + (size_t)2048 * DM * 2); S.lda = DM; S.ldb = DM; S.nN = 4; S.K = DM; E.C = MT + (size_t)NTOK * DM; }
            else { S.A = (const char*)yb; S.lda = DM; S.nN = 4; E.C = F;
                if (layer == 3) { S.Bt = (const char*)(ws + WS_W_D); S.ldb = 256; S.K = 256; S.ns = 1; S.apn = 256; E.scale = p->in[24]; }
                else { S.Bt = (const char*)(ws + (layer == 0 ? WS_W_A_OUT : (layer == 1 ? WS_W_B_OUT : WS_W_C_OUT))); S.ldb = DM; S.K = DM; S.ns = 4; } }
            pg8::gemm_phase(lds, S, E);
        } else if (kind == 3) {
            if (step == 2) phase_resnorm(h, F, FX, 11, 0.5f, g6 + 1 * DM, g6 + 2 * DM, hb, MT, (layer == 3) ? 1 : 0, gw, ngw, lane);
            else if (step == 7) phase_resnorm(h, F, FX, (layer == 3) ? 1 : 4, 1.0f, g6 + 3 * DM, g6 + 4 * DM, hb, nullptr, 0, gw, ngw, lane);
            else phase_resnorm(h, F, FX, 11, 0.5f, g6 + 5 * DM, g6 + 6 * DM  , hb, nullptr, (layer == 3) ? 2 : 0, gw, ngw, lane);
        } else if (kind == 4) phase_conv(p, MT, yb, lds, c, G, wave, lane);
        else if (kind == 5) phase_gate(p, MT, MT + (size_t)NTOK * DM, yb, gw, ngw, lane);
        else if (kind == 6) phase_vln(p, MT, vn, gw, ngw, lane);
        else if (kind == 7) phase_spatial(p, MT, vn, yb, lds, c, G, tid, wave, lane);
        else phase_pool(p, MT, yb, gw, ngw, lane);
        if (ph != NLAYER * 11 - 1) xcd_barrier(bar);
    }
}

extern "C" void kernel_launch(void* const* d_in, const int* in_sizes, int n_in, void* d_out, int out_size, void* d_ws, size_t ws_size, hipStream_t stream) {
    static int grid = 0;
    if (grid == 0) {
        if (n_in != 25 || (size_t)out_size != O_END || ws_size < WS_END) { fprintf(stderr, "kernel_launch: unexpected shapes (n_in %d out %d ws %zu need %zu)\n", n_in, out_size, ws_size, (size_t)WS_END); grid = -1; return; }
        int dev = 0, cus = 0, per_cu = 0;
        hipGetDevice(&dev); hipDeviceGetAttribute(&cus, hipDeviceAttributeMultiprocessorCount, dev);
        hipFuncSetAttribute((const void*)mega_fwd, hipFuncAttributeMaxDynamicSharedMemorySize, LDS_BYTES);
        hipOccupancyMaxActiveBlocksPerMultiprocessor(&per_cu, (const void*)mega_fwd, NTHREADS, LDS_BYTES);
        if (per_cu < 1) { fprintf(stderr, "kernel_launch: occupancy query says %d blocks per CU\n", per_cu); per_cu = 1; }
        (void)hipGetLastError();
        grid = cus;
    }
    if (grid < 0) return;
    hipMemsetAsync((char*)d_ws + WS_BAR, 0, 16384, stream);
    Params p{};
    for (int i = 0; i < 25; ++i) p.in[i] = (const float*)d_in[i];
    p.out = (float*)d_out; p.ws = (unsigned char*)d_ws;
    void* args[] = {&p};
    hipError_t e = hipLaunchCooperativeKernel((const void*)mega_fwd, dim3(grid), dim3(NTHREADS), args, LDS_BYTES, stream);
    if (e != hipSuccess) fprintf(stderr, "cooperative launch failed: %s (grid %d)\n", hipGetErrorString(e), grid);
}
```

```cpp
#include <hip/hip_runtime.h>
#include <hip/hip_cooperative_groups.h>
#include <cstdio>
#include <cstdint>
namespace cg = cooperative_groups;


#define LAS __attribute__((address_space(3)))
typedef unsigned short bf16_t;
typedef short bf16x8 __attribute__((ext_vector_type(8)));
typedef float f32x4 __attribute__((ext_vector_type(4)));
typedef float f32x2 __attribute__((ext_vector_type(2)));
typedef unsigned u32x4 __attribute__((ext_vector_type(4)));
typedef unsigned u32x2 __attribute__((ext_vector_type(2)));

constexpr int DM = 1024, DFF = 2816, TP = 16384, TS = 512, NTOK = TP + TS, NLAYER = 4;
constexpr float EPS = 1e-6f;
constexpr int NTHREADS = 512, NWAVES = 8;

constexpr size_t O_Y = 0;
constexpr size_t O_SA_P = (size_t)NTOK * DM;
constexpr size_t O_SA_S = O_SA_P + (size_t)8 * 30 * DM;
constexpr size_t O_SB_P = O_SA_S + (size_t)128 * 30 * DM;
constexpr size_t O_SB_S = O_SB_P + (size_t)8 * 2 * DM;
constexpr size_t O_SC_S = O_SB_S + (size_t)128 * 2 * DM;
constexpr size_t O_SP_P = O_SC_S + (size_t)128 * 4 * DM;
constexpr size_t O_SP_S = O_SP_P + (size_t)8 * 15 * DM;
constexpr size_t O_END = O_SP_S + (size_t)128 * 15 * DM;

constexpr size_t WS_BAR = 0;
constexpr size_t WS_CNT = 16384;
constexpr size_t WS_XBUF = 32768;
constexpr size_t WS_SS = WS_XBUF + (size_t)64 * 256 * 4 * 4;
constexpr size_t WS_W_FFN_IN = WS_SS + (size_t)NTOK * 4 * 4;
constexpr size_t SZ_FFN_IN = (size_t)2 * DFF * DM * 2;
constexpr size_t WS_W_FFN_DN = WS_W_FFN_IN + 8 * SZ_FFN_IN;
constexpr size_t SZ_FFN_DN = (size_t)DM * DFF * 2;
constexpr size_t WS_W_A_IN = WS_W_FFN_DN + 8 * SZ_FFN_DN;
constexpr size_t WS_W_A_OUT = WS_W_A_IN + (size_t)2048 * 1024 * 2;
constexpr size_t WS_W_B_IN = WS_W_A_OUT + (size_t)1024 * 1024 * 2;
constexpr size_t WS_W_B_OUT = WS_W_B_IN + (size_t)3072 * 1024 * 2;
constexpr size_t WS_W_C_IN = WS_W_B_OUT + (size_t)1024 * 1024 * 2;
constexpr size_t WS_W_C_OUT = WS_W_C_IN + (size_t)2048 * 1024 * 2;
constexpr size_t WS_W_D = WS_W_C_OUT + (size_t)1024 * 1024 * 2;
constexpr size_t WS_HB = WS_W_D + (size_t)1024 * 256 * 2;
constexpr size_t WS_ACT = WS_HB + (size_t)NTOK * DM * 2;
constexpr size_t WS_F = WS_ACT + (size_t)NTOK * DFF * 2;
constexpr size_t WS_FX = WS_F + (size_t)NTOK * DM * 4;
constexpr size_t WS_MT = WS_FX + (size_t)10 * TS * DM * 4;
constexpr size_t WS_END = WS_MT + (size_t)NTOK * 3072 * 4;

constexpr int LDS_TAB = 131072 + 64;
constexpr int LDS_BYTES = LDS_TAB + 5120 + 64;

struct Params { const float* in[25]; float* out; unsigned char* ws; };
typedef const Params __attribute__((address_space(4)))* KP;

__device__ __forceinline__ unsigned cvt_pk_bf16(float lo, float hi) { unsigned r; asm volatile("v_cvt_pk_bf16_f32 %0, %1, %2" : "=v"(r) : "v"(lo), "v"(hi)); return r; }
__device__ __forceinline__ float wave_sum(float v) {
#pragma unroll
    for (int o = 1; o < 64; o <<= 1) v += __shfl_xor(v, o);
    return v;
}
__device__ __forceinline__ void st16_wt(const void* base, size_t byteoff, u32x4 v) {
    const __amdgpu_buffer_rsrc_t r = __builtin_amdgcn_make_buffer_rsrc((void*)base, 0, 0xFFFFFFF0u, 0x00020000);
    __builtin_amdgcn_raw_buffer_store_b128(v, r, (unsigned)byteoff, 0, 16); }
__device__ __forceinline__ float sigmoid_f(float x) { return __builtin_amdgcn_rcpf(1.0f + __expf(-x)); }
__device__ __forceinline__ f32x2 gelu_pk(f32x2 v) {
    const f32x2 av = __builtin_elementwise_abs(v), d = av * 0.2316418882f + 1.0f;
    f32x2 t; t.x = __builtin_amdgcn_rcpf(d.x); t.y = __builtin_amdgcn_rcpf(d.y);
    f32x2 q = t * 0.5307027145f + (-0.7265760135f); q = q * t + 0.7107068705f; q = q * t + (-0.142248368f); q = q * t + 0.127414796f; q = q * t;
    const f32x2 s = (v * v) * (-0.72134752044f);
    f32x2 e; e.x = __builtin_amdgcn_exp2f(s.x); e.y = __builtin_amdgcn_exp2f(s.y);
    const f32x2 m = v * (q * e), r = v - m;
    f32x2 o; o.x = v.x < 0.f ? m.x : r.x; o.y = v.y < 0.f ? m.y : r.y; return o;
}

#define XB_TMO      128
#define XB_XCNT(j)  (256  + 64 * (j))
#define XB_XSUB(j)  (1280 + 64 * (j))
#define XB_XGEN(j)  (2304 + 64 * (j))
#define XB_TOP      3328
#define XB_TOPGEN   3392
#define XCD_BAR_WORDS 3456
#define XB_SPIN_CAP (1u << 20)
__device__ __forceinline__ unsigned xb_ld(unsigned* p)              { return __hip_atomic_load(p, __ATOMIC_RELAXED, __HIP_MEMORY_SCOPE_AGENT); }
__device__ __forceinline__ unsigned xb_add(unsigned* p, unsigned v) { return __hip_atomic_fetch_add(p, v, __ATOMIC_RELAXED, __HIP_MEMORY_SCOPE_AGENT); }
__device__ __forceinline__ unsigned xb_xcc_id() { return (unsigned)__builtin_amdgcn_s_getreg((3 << 11) | 20) & 0xFu; }
#define XB_SPIN(cond, bar) do { unsigned _sp = 0; while (cond) { __builtin_amdgcn_s_sleep(1); \
    if ((++_sp & 255u) == 0u) { if (xb_ld(&(bar)[XB_TMO])) break; if (_sp > XB_SPIN_CAP) { atomicAdd(&(bar)[XB_TMO], 1u); break; } } } } while (0)
struct XcdBarrier { unsigned* bar; unsigned x; volatile LAS unsigned* st; };
__device__ __forceinline__ XcdBarrier xcd_barrier_post(unsigned* bar, volatile LAS unsigned* st) {
    XcdBarrier b; b.bar = bar; b.x = xb_xcc_id(); b.st = st;
    if (threadIdx.x == 0) (void)xb_add(&bar[XB_XCNT(b.x)], 1u);
    return b;
}
__device__ __forceinline__ void xcd_barrier_complete(unsigned* bar, unsigned x, unsigned& nloc, unsigned& nx) {
    const unsigned G = gridDim.x * gridDim.y * gridDim.z;
    unsigned sum, cnt, mine, sp = 0u;
    for (;;) {
        sum = 0u; cnt = 0u; mine = 0u;
#pragma unroll
        for (unsigned j = 0; j < 16; ++j) { const unsigned c = xb_ld(&bar[XB_XCNT(j)]); sum += c; cnt += (c > 0u) ? 1u : 0u; mine = (j == x) ? c : mine; }
        if (sum == G) break;
        __builtin_amdgcn_s_sleep(1);
        if ((++sp & 255u) == 0u) { if (xb_ld(&bar[XB_TMO])) break; if (sp > XB_SPIN_CAP) { atomicAdd(&bar[XB_TMO], 1u); break; } }
    }
    nloc = mine > 0u ? mine : 1u; nx = cnt > 0u ? cnt : 1u;
}
__device__ __forceinline__ void xcd_barrier(const XcdBarrier& b) {
    asm volatile("s_waitcnt vmcnt(0)" ::: "memory");
    __syncthreads();
    if (threadIdx.x == 0) {
        unsigned* bar = b.bar;
        __builtin_amdgcn_s_waitcnt(0);
        unsigned nloc = b.st[0], nx = b.st[1];
        if (nloc == 0u) { xcd_barrier_complete(bar, b.x, nloc, nx); b.st[0] = nloc; b.st[1] = nx; }
        const unsigned old = xb_add(&bar[XB_XSUB(b.x)], 1u);
        const unsigned gen = old / nloc;
        if (old + 1u == (gen + 1u) * nloc) {
            __builtin_amdgcn_fence(__ATOMIC_RELEASE, "agent");
            asm volatile("s_waitcnt vmcnt(0)" ::: "memory");
            const unsigned og = xb_add(&bar[XB_TOP], 1u);
            const unsigned tg = og / nx;
            if (og + 1u == (tg + 1u) * nx) xb_add(&bar[XB_TOPGEN], 1u);
            else XB_SPIN(xb_ld(&bar[XB_TOPGEN]) == tg, bar);
            __builtin_amdgcn_fence(__ATOMIC_ACQUIRE, "agent");
            xb_add(&bar[XB_XGEN(b.x)], 1u);
            asm volatile("s_waitcnt vmcnt(0)" ::: "memory");
        } else {
            XB_SPIN(xb_ld(&bar[XB_XGEN(b.x)]) == gen, bar);
            __builtin_amdgcn_fence(__ATOMIC_ACQUIRE, "agent");
            asm volatile("s_waitcnt vmcnt(0)" ::: "memory");
        }
    }
    __syncthreads();
}

namespace pg8 {
constexpr int BM = 256, BK = 64, HALF = 128, HTB = HALF * BK * 2, STAGE_BYTES = 8 * HTB, NXCD = 8, WGM = 8;
__device__ __forceinline__ int lds_byte(int r, int c) { const int st = (r >> 4) * 2 + (c >> 5), rr = r & 15, cc = c & 31, ob = rr * 64 + cc * 2; return st * 1024 + (ob ^ (((ob >> 9) & 1) << 5)); }
__device__ __forceinline__ void stage_rc(int b, int& R, int& C) { const int st = b / 1024, sb = b % 1024, swz = sb ^ (((sb >> 9) & 1) << 5); R = (st >> 1) * 16 + swz / 64; C = (st & 1) * 32 + (swz % 64) / 2; }
__device__ __forceinline__ int perm32(int rho) { const int n = rho >> 4, i = rho & 15; return 8 * (i >> 2) + 4 * n + (i & 3); }

struct Unit { const char* a; const char* b; int pm, pn, z, nt; };

__device__ __forceinline__ void map_tile(int L, int nM, int nN, int& pm, int& pn) {
    const int nwg = nM * nN; int wgid = L;
    { const int q = nwg / NXCD, r = nwg % NXCD, xcd = wgid % NXCD, off = wgid / NXCD; wgid = (xcd < r ? xcd * (q + 1) : r * (q + 1) + (xcd - r) * q) + off; }
    const int nig = WGM * nN, gid = wgid / nig, fm = gid * WGM, gsz = (nM - fm) < WGM ? (nM - fm) : WGM;
    pm = fm + ((wgid % nig) % gsz); pn = (wgid % nig) / gsz;
}

struct Sched {
    const char* A; const char* Bt; int lda, ldb, nN, K, ns, apn, G, c, smode;
    __device__ __forceinline__ bool next(int i, Unit& u) const {
        const int L = i * G + c; int pm, pn, z = 0, nt;
        if (smode == 1) { if (L >= 66 * nN) return false; if (L < 2 * nN) { pm = 64 + (L & 1); pn = L >> 1; } else map_tile(L - 2 * nN, 64, nN, pm, pn); nt = K >> 6; }
        else if (smode == 2) { if (L >= 64 * nN) return false; map_tile(L, 64, nN, pm, pn); nt = K >> 6; }
        else if (smode == 3) { if (L >= 2 * nN * ns) return false; z = L / (2 * nN); const int r = L % (2 * nN); pm = 64 + r / nN; pn = r % nN; nt = (K / ns) >> 6; }
        else if (ns == 0) { if (L >= 66 * nN) return false; map_tile(L, 66, nN, pm, pn); nt = K >> 6; }
        else if (L < 64 * nN) { map_tile(L, 64, nN, pm, pn); nt = K >> 6; }
        else { const int e = L - 64 * nN; if (e >= 2 * nN * ns) return false; z = e / (2 * nN); const int r = e % (2 * nN); pm = 64 + r / nN; pn = r % nN; nt = (K / ns) >> 6; }
        const int ksub = nt * 64;
        u.a = A + ((size_t)pm * 256 * lda + (size_t)pn * apn + (size_t)z * ksub) * 2;
        u.b = Bt + ((size_t)pn * 256 * ldb + (size_t)z * ksub) * 2;
        u.pm = pm; u.pn = pn; u.z = z; u.nt = nt; return true;
    }
};

__device__ __forceinline__ float row_rs(const float* SS, int row) { const f32x4 q = *(const f32x4*)(SS + (size_t)row * 4); return __builtin_amdgcn_rsqf(((q.x + q.y) + (q.z + q.w)) * (1.0f / DM) + EPS); }

struct EpiF32 {
    static constexpr bool PERM = false;
    static constexpr bool USE_RS = true;
    float* C; int ldc; int act; const float* SS; float* vst;
    __device__ __forceinline__ void operator()(f32x4 (&acc)[2][2][4][2], const Unit& u, int wr, int wc, int fr, int fq, const LAS float* rstab) const {
        const int row0 = u.pm * BM + wr * 64 + fr, col0 = u.pn * BM + wc * 32 + 4 * fq;
        const bool stats = (vst != nullptr) && (u.pn >= 4);
        float rsv[2][4];
#pragma unroll
        for (int ai = 0; ai < 2; ++ai)
#pragma unroll
            for (int m = 0; m < 4; ++m) rsv[ai][m] = rstab[ai * HALF + wr * 64 + m * 16 + fr];
#pragma unroll
        for (int ai = 0; ai < 2; ++ai)
#pragma unroll
            for (int m = 0; m < 4; ++m) { const int row = row0 + ai * HALF + m * 16; const float rs = rsv[ai][m]; float* rowp = C + (size_t)row * ldc + col0; float s1 = 0.f, s2 = 0.f;
#pragma unroll
                for (int bj = 0; bj < 2; ++bj)
#pragma unroll
                    for (int n = 0; n < 2; ++n) { f32x4 v = acc[ai][bj][m][n] * rs;
                        if (act) { const f32x2 a = gelu_pk((f32x2){v[0], v[1]}), b = gelu_pk((f32x2){v[2], v[3]}); v = (f32x4){a.x, a.y, b.x, b.y}; }
                        s1 += (v[0] + v[1]) + (v[2] + v[3]); s2 += (v[0] * v[0] + v[1] * v[1]) + (v[2] * v[2] + v[3] * v[3]);
                        *(f32x4*)(rowp + bj * HALF + n * 16) = v; }
                if (stats) { s1 += __shfl_xor(s1, 16); s1 += __shfl_xor(s1, 32); s2 += __shfl_xor(s2, 16); s2 += __shfl_xor(s2, 32);
                    if (fq == 0) *(f32x2*)(vst + ((size_t)row * 16 + (u.pn - 4) * 4 + wc) * 2) = (f32x2){s1, s2}; } }
    }
};
struct EpiGated {
    static constexpr bool PERM = true;
    static constexpr bool USE_RS = true;
    bf16_t* O; float* OF; int ldo; int mode; const float* SS; int pn_plain; float* OF2; unsigned* pub;
    __device__ __forceinline__ void operator()(f32x4 (&acc)[2][2][4][2], const Unit& u, int wr, int wc, int fr, int fq, const LAS float* rstab) const {
        const int row0 = u.pm * BM + wr * 64 + fr, col0 = u.pn * HALF + wc * 32 + 8 * fq;
        float rs[2][4];
#pragma unroll
        for (int ai = 0; ai < 2; ++ai)
#pragma unroll
            for (int m = 0; m < 4; ++m) rs[ai][m] = rstab[ai * HALF + wr * 64 + m * 16 + fr];
        if (u.pn >= pn_plain) {
            const int c0 = (u.pn - pn_plain) * BM + wc * 32 + 8 * fq;
#pragma unroll
            for (int ai = 0; ai < 2; ++ai)
#pragma unroll
                for (int m = 0; m < 4; ++m) { float* rowp = OF2 + (size_t)(row0 + ai * HALF + m * 16) * DM + c0; const float r1 = rs[ai][m];
#pragma unroll
                    for (int bj = 0; bj < 2; ++bj)
#pragma unroll
                        for (int n = 0; n < 2; ++n) *(f32x4*)(rowp + bj * HALF + 4 * n) = acc[ai][bj][m][n] * r1; }
        } else if (mode == 0) {
            const bool wt = (pub != nullptr) && (u.pm >= 64);
#pragma unroll
            for (int ai = 0; ai < 2; ++ai)
#pragma unroll
                for (int m = 0; m < 4; ++m) { const size_t off = (size_t)(row0 + ai * HALF + m * 16) * ldo + col0; const float r1 = rs[ai][m], r2 = r1 * (-1.44269504f);
                    f32x4 r[2];
#pragma unroll
                    for (int n = 0; n < 2; ++n) { const f32x4 p = acc[ai][0][m][n], q = acc[ai][1][m][n];
#pragma unroll
                        for (int j = 0; j < 4; ++j) { const float e = __builtin_amdgcn_exp2f(p[j] * r2); r[n][j] = (p[j] * r1) * (q[j] * r1) * __builtin_amdgcn_rcpf(1.0f + e); } }
                    u32x4 w; w.x = cvt_pk_bf16(r[0][0], r[0][1]); w.y = cvt_pk_bf16(r[0][2], r[0][3]); w.z = cvt_pk_bf16(r[1][0], r[1][1]); w.w = cvt_pk_bf16(r[1][2], r[1][3]);
                    if (wt) st16_wt(O, off * 2, w); else *(u32x4*)(O + off) = w; }
        } else if (mode == 1) {
#pragma unroll
            for (int ai = 0; ai < 2; ++ai)
#pragma unroll
                for (int m = 0; m < 4; ++m) { const size_t off = (size_t)(row0 + ai * HALF + m * 16) * ldo + col0; const float r1 = rs[ai][m], r2 = r1 * (-1.44269504f);
#pragma unroll
                    for (int n = 0; n < 2; ++n) { const f32x4 p = acc[ai][0][m][n], q = acc[ai][1][m][n]; f32x4 r;
#pragma unroll
                        for (int j = 0; j < 4; ++j) { const float e = __builtin_amdgcn_exp2f(q[j] * r2); r[j] = (p[j] * r1) * __builtin_amdgcn_rcpf(1.0f + e); }
                        *(f32x4*)(OF + off + 4 * n) = r; } }
        } else {
#pragma unroll
            for (int ai = 0; ai < 2; ++ai)
#pragma unroll
                for (int m = 0; m < 4; ++m) { const size_t off = (size_t)(row0 + ai * HALF + m * 16) * ldo + col0; const float r1 = rs[ai][m] * rs[ai][m];
#pragma unroll
                    for (int n = 0; n < 2; ++n) *(f32x4*)(OF + off + 4 * n) = acc[ai][0][m][n] * acc[ai][1][m][n] * r1; }
        }
        if (pub && u.pm >= 64) {
            asm volatile("s_waitcnt vmcnt(0)" ::: "memory"); __builtin_amdgcn_s_barrier(); asm volatile("" ::: "memory");
            if (threadIdx.x == 0) __hip_atomic_fetch_add(pub, 1u, __ATOMIC_RELAXED, __HIP_MEMORY_SCOPE_AGENT);
        }
    }
};
struct EpiSlab {
    static constexpr bool PERM = false;
    static constexpr bool USE_RS = false;
    float* F; float* FX; const float* SS;
    __device__ __forceinline__ void operator()(f32x4 (&acc)[2][2][4][2], const Unit& u, int wr, int wc, int fr, int fq, const LAS float*) const {
        const int row0 = u.pm * BM + wr * 64 + fr, col0 = u.pn * BM + wc * 32 + 4 * fq;
        float* base = (u.z == 0) ? F + (size_t)row0 * DM : FX + ((size_t)(u.z - 1) * TS + (row0 - TP)) * DM;
#pragma unroll
        for (int ai = 0; ai < 2; ++ai)
#pragma unroll
            for (int m = 0; m < 4; ++m) { float* rowp = base + (size_t)(ai * HALF + m * 16) * DM + col0;
#pragma unroll
                for (int bj = 0; bj < 2; ++bj)
#pragma unroll
                    for (int n = 0; n < 2; ++n) *(f32x4*)(rowp + bj * HALF + n * 16) = acc[ai][bj][m][n]; }
    }
};
struct EpiResNorm {
    static constexpr bool PERM = true;
    static constexpr bool USE_RS = false;
    float* h; const float* hsrc; bf16_t* hb; float* SS; float* F; float* FX; const float* gA; const float* gB; const float* cscale; float scale; int last;
    float* xbuf; unsigned* cnt; unsigned target; LAS float* tab;
    __device__ __forceinline__ void operator()(f32x4 (&acc)[2][2][4][2], const Unit& u, int wr_, int wc_, int fr_, int fq_, const LAS float*) const {
        int tid = threadIdx.x; asm volatile("" : "+v"(tid));
        const int lane = tid & 63, wid = __builtin_amdgcn_readfirstlane(tid >> 6), wr = wid >> 2, wc = wid & 3, fr = lane & 15, fq = lane >> 4;
        (void)wr_; (void)wc_; (void)fr_; (void)fq_;
        const int col0 = u.pn * BM + wc * 32 + 8 * fq;
        if (cscale) {
#pragma unroll
            for (int bj = 0; bj < 2; ++bj)
#pragma unroll
                for (int n = 0; n < 2; ++n) { const f32x4 sv = *(const f32x4*)(cscale + col0 + bj * HALF + n * 4);
#pragma unroll
                    for (int ai = 0; ai < 2; ++ai)
#pragma unroll
                        for (int m = 0; m < 4; ++m) acc[ai][bj][m][n] *= sv; }
        }
        if (u.pm >= 64) {
            const int row0 = u.pm * BM + wr * 64 + fr;
            float* base = (u.z == 0) ? F + (size_t)row0 * DM : FX + ((size_t)(u.z - 1) * TS + (row0 - TP)) * DM;
#pragma unroll
            for (int ai = 0; ai < 2; ++ai)
#pragma unroll
                for (int m = 0; m < 4; ++m) { float* rowp = base + (size_t)(ai * HALF + m * 16) * DM + col0;
#pragma unroll
                    for (int bj = 0; bj < 2; ++bj)
#pragma unroll
                        for (int n = 0; n < 2; ++n) *(f32x4*)(rowp + bj * HALF + n * 4) = acc[ai][bj][m][n]; }
            return;
        }
        LAS float* P = tab; LAS float* S = tab + 1024;
        f32x4 hbuf[2][4], gav[4], gbv[4];
        { const size_t off0 = (size_t)(u.pm * BM + wr * 64 + fr) * DM + col0;
#pragma unroll
            for (int q = 0; q < 4; ++q) { const int cc = (q >> 1) * HALF + (q & 1) * 4; hbuf[0][q] = *(const f32x4*)(hsrc + off0 + cc); gav[q] = *(const f32x4*)(gA + col0 + cc); gbv[q] = last ? (f32x4){0.f, 0.f, 0.f, 0.f} : *(const f32x4*)(gB + col0 + cc); } }
        f32x4 warm = (f32x4){0.f, 0.f, 0.f, 0.f};
#pragma unroll 1
        for (int g = 1; g < 8; ++g) { const float* hp = hsrc + (size_t)(u.pm * BM + (g >> 2) * HALF + wr * 64 + (g & 3) * 16 + fr) * DM + col0;
            asm volatile("global_load_dwordx4 %0, %1, off\n\tglobal_load_dwordx4 %0, %1, off offset:16\n\tglobal_load_dwordx4 %0, %1, off offset:512\n\tglobal_load_dwordx4 %0, %1, off offset:528" : "+v"(warm) : "v"(hp) : "memory"); }
#pragma unroll
        for (int ai = 0; ai < 2; ++ai)
#pragma unroll
            for (int m = 0; m < 4; ++m) { float s = 0.f;
#pragma unroll
                for (int bj = 0; bj < 2; ++bj)
#pragma unroll
                    for (int n = 0; n < 2; ++n) { const f32x4 x = acc[ai][bj][m][n]; s += (x[0] * x[0] + x[1] * x[1]) + (x[2] * x[2] + x[3] * x[3]); }
                s += __shfl_xor(s, 16); s += __shfl_xor(s, 32);
                if (fq == 0) P[(ai * HALF + wr * 64 + m * 16 + fr) * 4 + wc] = s; }
        asm volatile("s_waitcnt lgkmcnt(0)" ::: "memory"); __builtin_amdgcn_s_barrier(); asm volatile("" ::: "memory");
        const int row = wid * 32 + (lane & 31);
        if (lane < 32) { const f32x4 pp = *(const LAS f32x4*)(P + row * 4);
            __hip_atomic_store(xbuf + ((size_t)(u.pm * BM + row) * 4 + u.pn), (pp.x + pp.y) + (pp.z + pp.w), __ATOMIC_RELAXED, __HIP_MEMORY_SCOPE_AGENT); }
        asm volatile("s_waitcnt vmcnt(0)" : "+v"(warm) :: "memory");
        if (lane == 0) __hip_atomic_fetch_add(cnt + 64 * u.pm, 1u, __ATOMIC_RELAXED, __HIP_MEMORY_SCOPE_AGENT);
        if (wid == 0) {
            unsigned sp = 0;
            while ((unsigned)__builtin_amdgcn_readfirstlane(__hip_atomic_load(cnt + 64 * u.pm, __ATOMIC_RELAXED, __HIP_MEMORY_SCOPE_AGENT)) < target) { __builtin_amdgcn_s_sleep(1); if (++sp > (1u << 22)) break; }
            __builtin_amdgcn_fence(__ATOMIC_ACQUIRE, "agent");
        }
        asm volatile("s_waitcnt vmcnt(0) lgkmcnt(0)" ::: "memory"); __builtin_amdgcn_s_barrier(); asm volatile("" ::: "memory");
        if (lane < 32) { const float* slot = xbuf + (size_t)(u.pm * BM + row) * 4; float tot = 0.f;
#pragma unroll
            for (int t = 0; t < 4; ++t) tot += __hip_atomic_load(slot + t, __ATOMIC_RELAXED, __HIP_MEMORY_SCOPE_AGENT);
            S[row] = scale * __builtin_amdgcn_rsqf(tot * (1.0f / DM) + EPS); }
        asm volatile("s_waitcnt vmcnt(0) lgkmcnt(0)" ::: "memory"); __builtin_amdgcn_s_barrier(); asm volatile("" ::: "memory");
#pragma unroll
        for (int g = 0; g < 8; ++g) { const int ai = g >> 2, m = g & 3;
            if (g + 1 < 8) { const int ai2 = (g + 1) >> 2, m2 = (g + 1) & 3; const size_t off2 = (size_t)(u.pm * BM + ai2 * HALF + wr * 64 + m2 * 16 + fr) * DM + col0;
#pragma unroll
                for (int q = 0; q < 4; ++q) hbuf[(g + 1) & 1][q] = *(const f32x4*)(hsrc + off2 + (q >> 1) * HALF + (q & 1) * 4); }
            asm volatile("" ::: "memory");
            const int r = ai * HALF + wr * 64 + m * 16 + fr; const float rs = S[r]; const size_t off = (size_t)(u.pm * BM + r) * DM + col0; float s2 = 0.f;
#pragma unroll
            for (int bj = 0; bj < 2; ++bj) { u32x4 w4;
#pragma unroll
                for (int n = 0; n < 2; ++n) { const int q = 2 * bj + n, cc = bj * HALF + n * 4;
                    const f32x4 hv = hbuf[g & 1][q] + acc[ai][bj][m][n] * rs * gav[q]; *(f32x4*)(h + off + cc) = hv;
                    s2 += (hv[0] * hv[0] + hv[1] * hv[1]) + (hv[2] * hv[2] + hv[3] * hv[3]);
                    const f32x4 x = hv * gbv[q]; if (n == 0) { w4.x = cvt_pk_bf16(x[0], x[1]); w4.y = cvt_pk_bf16(x[2], x[3]); } else { w4.z = cvt_pk_bf16(x[0], x[1]); w4.w = cvt_pk_bf16(x[2], x[3]); } }
                if (!last) *(u32x4*)(hb + off + bj * HALF) = w4; }
            s2 += __shfl_xor(s2, 16); s2 += __shfl_xor(s2, 32);
            if (fq == 0) P[r * 4 + wc] = s2;
            asm volatile("" ::: "memory"); }
        asm volatile("s_waitcnt lgkmcnt(0)" ::: "memory"); __builtin_amdgcn_s_barrier(); asm volatile("" ::: "memory");
        if (lane < 32) { const f32x4 pp = *(const LAS f32x4*)(P + row * 4); SS[(size_t)(u.pm * BM + row) * 4 + u.pn] = (pp.x + pp.y) + (pp.z + pp.w); }
        asm volatile("s_waitcnt lgkmcnt(0)" ::: "memory"); __builtin_amdgcn_s_barrier(); asm volatile("" ::: "memory");
    }
};

template <class Epi>
__device__ __forceinline__ void gemm_phase(LAS unsigned char* lds, const Sched& S, const Epi& E, unsigned long long* probe = nullptr) {
    int tid = threadIdx.x; asm volatile("" : "+v"(tid));
    const int wid = __builtin_amdgcn_readfirstlane(tid >> 6), lane = tid & 63, wr = wid >> 2, wc = wid & 3, fr = lane & 15, fq = lane >> 4;
    const int lda = S.lda, ldb = S.ldb;
    unsigned voffA[2], voffB[2];
#pragma unroll
    for (int i = 0; i < 2; ++i) { int R, C; stage_rc(tid * 16 + i * 8192, R, C); const int Rb = Epi::PERM ? ((R & ~31) + perm32(R & 31)) : R;
        voffA[i] = (unsigned)(R * lda + C) * 2u; voffB[i] = (unsigned)(Rb * ldb + C) * 2u; }
    const size_t kstep = (size_t)(BK * 2);
    const size_t hstepA = (size_t)HALF * lda * 2, hstepB = (size_t)HALF * ldb * 2;
    const unsigned ldsw = (unsigned)wid * 1024u;
    const int aoff = lds_byte(wr * 64 + fr, fq * 8), boff = lds_byte(wc * 32 + fr, fq * 8);
#define PG8_SA(b, h) (((b) * 2 + (h)) * HTB)
#define PG8_SB(b, h) ((4 + (b) * 2 + (h)) * HTB)
#define PG8_STAGE(bufoff, gbase, voff) do { _Pragma("unroll") for (int _i = 0; _i < 2; ++_i) \
        __builtin_amdgcn_global_load_lds((const unsigned*)((const char*)(gbase) + (voff)[_i]), (LAS unsigned*)(lds + (bufoff) + ldsw + _i * 8192), 16, 0, 0); } while (0)
#define PG8_LDA(dst, b, h) do { _Pragma("unroll") for (int m = 0; m < 4; ++m) _Pragma("unroll") for (int k = 0; k < 2; ++k) dst[m][k] = *(const LAS bf16x8*)(lds + PG8_SA(b, h) + aoff + m * 2048 + k * 1024); } while (0)
#define PG8_LDB(dst, b, h) do { _Pragma("unroll") for (int n = 0; n < 2; ++n) _Pragma("unroll") for (int k = 0; k < 2; ++k) dst[n][k] = *(const LAS bf16x8*)(lds + PG8_SB(b, h) + boff + n * 2048 + k * 1024); } while (0)
#define PG8_MMA(ai, bj, At, Bt) do { __builtin_amdgcn_s_setprio(1); _Pragma("unroll") for (int m = 0; m < 4; ++m) _Pragma("unroll") for (int n = 0; n < 2; ++n) _Pragma("unroll") for (int k = 0; k < 2; ++k) \
        acc[ai][bj][m][n] = __builtin_amdgcn_mfma_f32_16x16x32_bf16(Bt[n][k], At[m][k], acc[ai][bj][m][n], 0, 0, 0); __builtin_amdgcn_s_setprio(0); } while (0)
#define PG8_WAIT_V(n) asm volatile("s_waitcnt vmcnt(" #n ")" ::: "memory")
#define PG8_WAIT_L(n) asm volatile("s_waitcnt lgkmcnt(" #n ")" ::: "memory")
#define PG8_BAR __builtin_amdgcn_s_barrier()
#define PG8_SCHED __builtin_amdgcn_sched_barrier(0)
    Unit cur, nxt; int ui = 0;
    if (!S.next(0, cur)) return;
    f32x4 acc[2][2][4][2];
#pragma unroll
    for (int a = 0; a < 2; ++a)
#pragma unroll
        for (int b = 0; b < 2; ++b)
#pragma unroll
            for (int m = 0; m < 4; ++m)
#pragma unroll
                for (int n = 0; n < 2; ++n) acc[a][b][m][n] = (f32x4){0.f, 0.f, 0.f, 0.f};
    bf16x8 At[4][2], B0[2][2], B1[2][2];
    const char* cA = cur.a; const char* cB = cur.b;
    LAS float* rstab = (LAS float*)(lds + LDS_TAB);
    if constexpr (Epi::USE_RS) { if (tid < 256) rstab[tid] = row_rs(E.SS, cur.pm * BM + tid); }
    PG8_STAGE(PG8_SB(0, 0), cB, voffB); PG8_STAGE(PG8_SB(0, 1), cB + hstepB, voffB); PG8_STAGE(PG8_SA(0, 0), cA, voffA); PG8_STAGE(PG8_SA(0, 1), cA + hstepA, voffA);
    if (wr == 1) PG8_BAR;
    PG8_WAIT_V(2); PG8_BAR;
    PG8_STAGE(PG8_SB(1, 0), cB + kstep, voffB); PG8_STAGE(PG8_SA(1, 0), cA + kstep, voffA); PG8_STAGE(PG8_SB(1, 1), cB + hstepB + kstep, voffB);
    PG8_WAIT_V(6); PG8_BAR;
    for (;;) {
        const bool has_next = S.next(ui + 1, nxt);
        const char* nA = has_next ? nxt.a : cA; const char* nB = has_next ? nxt.b : cB;
        const int nt = cur.nt;
        for (int t = 0; t < nt; t += 2) {
            const bool last = (t == nt - 2);
            const char* a1 = cA + (size_t)(t + 1) * kstep;
            const char* a2 = last ? nA : cA + (size_t)(t + 2) * kstep; const char* b2 = last ? nB : cB + (size_t)(t + 2) * kstep;
            const char* a3 = a2 + kstep; const char* b3 = b2 + kstep;
            PG8_LDB(B0, 0, 0); PG8_LDB(B1, 0, 1); PG8_SCHED; PG8_LDA(At, 0, 0); PG8_STAGE(PG8_SA(1, 1), a1 + hstepA, voffA);
            PG8_WAIT_V(8); PG8_WAIT_L(0); PG8_BAR; PG8_MMA(0, 0, At, B0); PG8_MMA(0, 1, At, B1); PG8_BAR; PG8_SCHED;
            PG8_LDA(At, 0, 1); PG8_STAGE(PG8_SB(0, 0), b2, voffB); PG8_STAGE(PG8_SB(0, 1), b2 + hstepB, voffB); PG8_STAGE(PG8_SA(0, 0), a2, voffA);
            PG8_WAIT_V(8); PG8_WAIT_L(0); PG8_BAR; PG8_MMA(1, 0, At, B0); PG8_MMA(1, 1, At, B1); PG8_BAR; PG8_SCHED;
            PG8_LDB(B0, 1, 0); PG8_LDB(B1, 1, 1); PG8_SCHED; PG8_LDA(At, 1, 0); PG8_STAGE(PG8_SA(0, 1), a2 + hstepA, voffA);
            PG8_WAIT_V(8); PG8_WAIT_L(0); PG8_BAR; PG8_MMA(0, 0, At, B0); PG8_MMA(0, 1, At, B1); PG8_BAR; PG8_SCHED;
            PG8_LDA(At, 1, 1); PG8_STAGE(PG8_SB(1, 0), b3, voffB); PG8_STAGE(PG8_SB(1, 1), b3 + hstepB, voffB); PG8_STAGE(PG8_SA(1, 0), a3, voffA);
            PG8_WAIT_V(8); PG8_WAIT_L(0); PG8_BAR; PG8_MMA(1, 0, At, B0); PG8_MMA(1, 1, At, B1); PG8_BAR; PG8_SCHED;
        }
        if (wr == 0) PG8_BAR;
#ifdef PROBE_CLASS
        unsigned long long pe0 = 0; if (probe) { asm volatile("s_waitcnt vmcnt(0)" ::: "memory"); pe0 = __builtin_amdgcn_s_memrealtime(); }
#endif
        f32x4 ssn = (f32x4){0.f, 0.f, 0.f, 0.f};
        if constexpr (Epi::USE_RS) { if (has_next && tid < 256) ssn = *(const f32x4*)(E.SS + (size_t)(nxt.pm * BM + tid) * 4); }
        E(acc, cur, wr, wc, fr, fq, rstab + (ui & 1) * 256);
        if constexpr (Epi::USE_RS) { if (has_next && tid < 256) rstab[((ui + 1) & 1) * 256 + tid] = __builtin_amdgcn_rsqf(((ssn.x + ssn.y) + (ssn.z + ssn.w)) * (1.0f / DM) + EPS); }
#ifdef PROBE_CLASS
        if (probe) { asm volatile("s_waitcnt vmcnt(0)" ::: "memory"); if (blockIdx.x == 0 && threadIdx.x == 0) *probe += __builtin_amdgcn_s_memrealtime() - pe0; }
#endif
        if (!has_next) break;
#pragma unroll
        for (int a = 0; a < 2; ++a)
#pragma unroll
            for (int b = 0; b < 2; ++b)
#pragma unroll
                for (int m = 0; m < 4; ++m)
#pragma unroll
                    for (int n = 0; n < 2; ++n) acc[a][b][m][n] = (f32x4){0.f, 0.f, 0.f, 0.f};
        cur = nxt; cA = nA; cB = nB; ++ui;
        if (wr == 1) PG8_BAR;
    }
    PG8_WAIT_V(0);
    PG8_BAR;
#undef PG8_SA
#undef PG8_SB
#undef PG8_STAGE
#undef PG8_LDA
#undef PG8_LDB
#undef PG8_MMA
#undef PG8_WAIT_V
#undef PG8_WAIT_L
#undef PG8_BAR
#undef PG8_SCHED
}
}

#define LDS_WAIT() asm volatile("s_waitcnt lgkmcnt(0)" ::: "memory")
__device__ __forceinline__ void transpose_item(const float* W, int N, bf16_t* WT, int K, int k0, int n0, int r0, LAS float* scr, int lane) {
    float wv[32];
#pragma unroll
    for (int i = 0; i < 32; ++i) wv[i] = W[(size_t)(k0 + 2 * i + (lane >> 5)) * N + n0 + (lane & 31)];
#pragma unroll
    for (int i = 0; i < 32; ++i) scr[(2 * i + (lane >> 5)) * 33 + (lane & 31)] = wv[i];
    LDS_WAIT();
    const int c = lane & 7;
#pragma unroll
    for (int j = 0; j < 4; ++j) { const int n = (lane >> 3) + 8 * j; const LAS float* s = scr + (8 * c) * 33 + n;
        u32x4 o; o.x = cvt_pk_bf16(s[0 * 33], s[1 * 33]); o.y = cvt_pk_bf16(s[2 * 33], s[3 * 33]); o.z = cvt_pk_bf16(s[4 * 33], s[5 * 33]); o.w = cvt_pk_bf16(s[6 * 33], s[7 * 33]);
        *(u32x4*)(WT + (size_t)(r0 + n) * K + k0 + 8 * c) = o; }
    LDS_WAIT();
}
__device__ __forceinline__ void convert_matrix(const float* W, int K, int N, int half, bf16_t* WT, int item, LAS float* scr, int lane) {
    const int nblk = N / 32, kb = item / nblk, nb = item % nblk, r0 = nb * 32;
    const int n0 = half ? (((r0 >> 7) & 1) * half + (r0 >> 8) * 128 + (r0 & 127)) : r0;
    transpose_item(W, N, WT, K, kb * 64, n0, r0, scr, lane);
}

__device__ __forceinline__ void phase_prologue(KP p, LAS unsigned char* lds, int gw, int ngw, int wave, int lane) {
    LAS float* scr = (LAS float*)(lds + wave * 16384);
    unsigned char* ws = p->ws;
    constexpr int I_FIN = 16 * 176, I_FDN = 44 * 32, I_AIN = 16 * 64, I_SQ = 16 * 32, I_BIN = 16 * 96, I_D = 4 * 8;
    constexpr int NITEMS = 8 * I_FIN + 8 * I_FDN + I_AIN + I_SQ + I_BIN + I_SQ + I_AIN + I_SQ + 4 * I_D;
    for (int it = gw; it < NITEMS; it += ngw) {
        int r = it;
        if (r < 8 * I_FIN) { const int m = r / I_FIN; if (m >= 1) continue;
            convert_matrix(p->in[6] + (size_t)m * DM * 2 * DFF, DM, 2 * DFF, DFF, (bf16_t*)(ws + WS_W_FFN_IN + m * SZ_FFN_IN), r % I_FIN, scr, lane); continue; } r -= 8 * I_FIN;
        if (r < 8 * I_FDN) { const int m = r / I_FDN; if (m == 1 || (m >= 2 && (r % I_FDN) < 1344)) continue;
            convert_matrix(p->in[7] + (size_t)m * DFF * DM, DFF, DM, 0, (bf16_t*)(ws + WS_W_FFN_DN + m * SZ_FFN_DN), r % I_FDN, scr, lane); continue; } r -= 8 * I_FDN;
        if (r < I_AIN + I_SQ) continue;
        r -= I_AIN + I_SQ;
        if (r < I_BIN + I_SQ + I_AIN + I_SQ + 4 * I_D) continue;
        if (r < I_BIN) {
            const int nblk = 96, kb = r / nblk, nb = r % nblk, r0 = nb * 32;
            const int n0 = (r0 < 2048) ? (1024 + ((r0 >> 7) & 1) * 1024 + (r0 >> 8) * 128 + (r0 & 127)) : (r0 - 2048);
            transpose_item(p->in[14], 3072, (bf16_t*)(ws + WS_W_B_IN), DM, kb * 64, n0, r0, scr, lane); continue; } r -= I_BIN;
        if (r < I_SQ) { convert_matrix(p->in[16], DM, DM, 0, (bf16_t*)(ws + WS_W_B_OUT), r, scr, lane); continue; } r -= I_SQ;
        if (r < I_AIN) { convert_matrix(p->in[17], DM, 2048, 0, (bf16_t*)(ws + WS_W_C_IN), r, scr, lane); continue; } r -= I_AIN;
        if (r < I_SQ) { convert_matrix(p->in[22], DM, DM, 0, (bf16_t*)(ws + WS_W_C_OUT), r, scr, lane); continue; } r -= I_SQ;
        { const int g = r / I_D; convert_matrix(p->in[23] + (size_t)g * 65536, 256, 256, 0, (bf16_t*)(ws + WS_W_D) + (size_t)g * 65536, r % I_D, scr, lane); }
    }
    bf16_t* hb = (bf16_t*)(ws + WS_HB); const float* g0 = p->in[5];
    for (int t = gw; t < NTOK; t += ngw) {
        const float* src = (t < TP) ? p->in[0] + (size_t)t * DM : p->in[1] + (size_t)(t - TP) * DM;
        const f32x4* xr = (const f32x4*)src + lane; f32x4 v[4]; float ss = 0.f;
#pragma unroll
        for (int j = 0; j < 4; ++j) { v[j] = xr[64 * j]; ss += (v[j].x * v[j].x + v[j].y * v[j].y) + (v[j].z * v[j].z + v[j].w * v[j].w); }
        ss = wave_sum(ss);
        if (lane == 0) *(f32x4*)((float*)(ws + WS_SS) + (size_t)t * 4) = (f32x4){ss, 0.f, 0.f, 0.f};
        u32x2* ob = (u32x2*)(hb + (size_t)t * DM) + lane;
#pragma unroll
        for (int j = 0; j < 4; ++j) { const f32x4 g = ((const f32x4*)g0)[lane + 64 * j]; const f32x4 x = v[j] * g;
            u32x2 w; w.x = cvt_pk_bf16(x.x, x.y); w.y = cvt_pk_bf16(x.z, x.w); ob[64 * j] = w; }
    }
}

__device__ __forceinline__ void convert_mixer_weights(KP p, int nl, LAS unsigned char* lds, int gwx, int ngwx, int wave, int lane) {
    LAS float* scr = (LAS float*)(lds + wave * 16384); unsigned char* ws = p->ws;
    constexpr int I_AIN = 16 * 64, I_SQ = 16 * 32, I_BIN = 16 * 96, I_D = 4 * 8;
    const int n = (nl == 1) ? I_BIN + I_SQ : (nl == 2 ? I_AIN + I_SQ : 4 * I_D);
    for (int it = gwx; it < n; it += ngwx) { int r = it;
        if (nl == 1) {
            if (r < I_BIN) { const int nblk = 96, kb = r / nblk, nb = r % nblk, r0 = nb * 32;
                const int n0 = (r0 < 2048) ? (1024 + ((r0 >> 7) & 1) * 1024 + (r0 >> 8) * 128 + (r0 & 127)) : (r0 - 2048);
                transpose_item(p->in[14], 3072, (bf16_t*)(ws + WS_W_B_IN), DM, kb * 64, n0, r0, scr, lane); }
            else convert_matrix(p->in[16], DM, DM, 0, (bf16_t*)(ws + WS_W_B_OUT), r - I_BIN, scr, lane);
        } else if (nl == 2) {
            if (r < I_AIN) convert_matrix(p->in[17], DM, 2048, 0, (bf16_t*)(ws + WS_W_C_IN), r, scr, lane);
            else convert_matrix(p->in[22], DM, DM, 0, (bf16_t*)(ws + WS_W_C_OUT), r - I_AIN, scr, lane);
        } else { const int g = r / I_D; convert_matrix(p->in[23] + (size_t)g * 65536, 256, 256, 0, (bf16_t*)(ws + WS_W_D) + (size_t)g * 65536, r % I_D, scr, lane); }
    }
}
__device__ __forceinline__ void convert_ffn_in_layer(KP p, int nl, LAS unsigned char* lds, int gwx, int ngwx, int wave, int lane) {
    LAS float* scr = (LAS float*)(lds + wave * 16384);
    constexpr int I_FIN = 16 * 176;
    for (int it = gwx; it < 2 * I_FIN; it += ngwx) { const int m = 2 * nl + it / I_FIN;
        convert_matrix(p->in[6] + (size_t)m * DM * 2 * DFF, DM, 2 * DFF, DFF, (bf16_t*)(p->ws + WS_W_FFN_IN + m * SZ_FFN_IN), it % I_FIN, scr, lane); }
}

__device__ __forceinline__ void phase_resnorm_sample(float* h, const float* hsrc, const float* F, const float* FX, int ns, float scale, const float* gA, const float* gB,
                                                     bf16_t* hb, float* SS, int last, int gw, int ngw, int lane) {
    for (int t = TP + gw; t < NTOK; t += ngw) {
        const f32x4* fr = (const f32x4*)(F + (size_t)t * DM) + lane; f32x4 f[4];
#pragma unroll
        for (int j = 0; j < 4; ++j) f[j] = fr[64 * j];
#pragma unroll
        for (int zb = 0; zb < 2; ++zb) { f32x4 tmp[5][4];
#pragma unroll
            for (int k = 0; k < 5; ++k) { const int z = 1 + zb * 5 + k; const f32x4* xr = (const f32x4*)(FX + ((size_t)((z < ns ? z : 1) - 1) * TS + (t - TP)) * DM) + lane;
#pragma unroll
                for (int j = 0; j < 4; ++j) tmp[k][j] = xr[64 * j]; }
#pragma unroll
            for (int k = 0; k < 5; ++k) { const float fac = (1 + zb * 5 + k < ns) ? 1.0f : 0.0f;
#pragma unroll
                for (int j = 0; j < 4; ++j) f[j] += tmp[k][j] * fac; } }
        float ss = 0.f;
#pragma unroll
        for (int j = 0; j < 4; ++j) ss += (f[j].x * f[j].x + f[j].y * f[j].y) + (f[j].z * f[j].z + f[j].w * f[j].w);
        const float rs = scale / sqrtf(wave_sum(ss) * (1.0f / DM) + EPS);
        f32x4* hr = (f32x4*)(h + (size_t)t * DM) + lane; const f32x4* hs = (const f32x4*)(hsrc + (size_t)t * DM) + lane; f32x4 hv[4]; float s2 = 0.f;
#pragma unroll
        for (int j = 0; j < 4; ++j) { const f32x4 g = ((const f32x4*)gA)[lane + 64 * j]; hv[j] = hs[64 * j] + f[j] * rs * g; hr[64 * j] = hv[j];
            s2 += (hv[j].x * hv[j].x + hv[j].y * hv[j].y) + (hv[j].z * hv[j].z + hv[j].w * hv[j].w); }
        if (!last) {
            s2 = wave_sum(s2);
            if (lane == 0) *(f32x4*)(SS + (size_t)t * 4) = (f32x4){s2, 0.f, 0.f, 0.f};
            u32x2* ob = (u32x2*)(hb + (size_t)t * DM) + lane;
#pragma unroll
            for (int j = 0; j < 4; ++j) { const f32x4 g = ((const f32x4*)gB)[lane + 64 * j]; const f32x4 x = hv[j] * g;
                u32x2 w; w.x = cvt_pk_bf16(x.x, x.y); w.y = cvt_pk_bf16(x.z, x.w); ob[64 * j] = w; }
        }
    }
}

__device__ __forceinline__ void phase_conv(KP p, const float* glu, bf16_t* yb, LAS unsigned char* lds, int c, int G, int wave, int lane) {
    const float* state_a = p->in[2]; const float* cw = p->in[9]; const float* cbias = p->in[10]; const float* lg = p->in[11]; const float* lb = p->in[12];
    LAS float* buf = (LAS float*)lds;
    const int ch = wave * 128 + lane * 2;
    f32x2 w[31];
#pragma unroll
    for (int j = 0; j < 31; ++j) w[j] = *(const f32x2*)(cw + j * DM + ch);
    const f32x2 bias = *(const f32x2*)(cbias + ch);
    for (int gp = c; gp < NTOK / 8; gp += G) {
#pragma unroll 1
        for (int gsel = 0; gsel < 2; ++gsel) {
            const int t0 = 8 * gp + 4 * gsel; const bool samp = t0 >= TP;
            const int b = samp ? ((t0 - TP) >> 2) : (t0 >> 11), s0 = samp ? 0 : (t0 & 2047);
            f32x2 acc[4] = {bias, bias, bias, bias};
#pragma unroll
            for (int r = 0; r < 34; ++r) {
                const int rel = r - 30;
                const float* ptr; float fac = 1.0f;
                if (rel >= 0) ptr = glu + (size_t)(t0 + rel) * DM;
                else if (samp) ptr = state_a + ((size_t)b * 30 + 30 + rel) * DM;
                else { const bool ok = (s0 + rel >= 0); ptr = glu + (size_t)(ok ? t0 + rel : t0) * DM; fac = ok ? 1.0f : 0.0f; }
                f32x2 x = *(const f32x2*)(ptr + ch); if (rel < 0) x = x * fac;
#pragma unroll
                for (int o = 0; o < 4; ++o) { const int j = r - o; if (j >= 0 && j <= 30) acc[o] += w[j] * x; }
            }
#pragma unroll
            for (int o = 0; o < 4; ++o) *(LAS f32x2*)(buf + (gsel * 4 + o) * DM + ch) = acc[o];
        }
        __syncthreads();
        {
            const int t = 8 * gp + wave; const LAS f32x4* br = (const LAS f32x4*)(buf + wave * DM) + lane; f32x4 v[4]; float s = 0.f;
#pragma unroll
            for (int j = 0; j < 4; ++j) { v[j] = br[64 * j]; s += (v[j].x + v[j].y) + (v[j].z + v[j].w); }
            const float mean = wave_sum(s) * (1.0f / DM); float s2 = 0.f;
#pragma unroll
            for (int j = 0; j < 4; ++j) { v[j] = v[j] - mean; s2 += (v[j].x * v[j].x + v[j].y * v[j].y) + (v[j].z * v[j].z + v[j].w * v[j].w); }
            const float rstd = 1.0f / sqrtf(wave_sum(s2) * (1.0f / DM) + EPS);
            u32x2* ob = (u32x2*)(yb + (size_t)t * DM) + lane;
#pragma unroll
            for (int j = 0; j < 4; ++j) { const f32x4 g = ((const f32x4*)lg)[lane + 64 * j], bb = ((const f32x4*)lb)[lane + 64 * j]; f32x4 y = v[j] * rstd * g + bb;
#pragma unroll
                for (int e = 0; e < 4; ++e) y[e] = y[e] * sigmoid_f(y[e]);
                u32x2 o; o.x = cvt_pk_bf16(y.x, y.y); o.y = cvt_pk_bf16(y.z, y.w); ob[64 * j] = o; }
        }
        __syncthreads();
    }
    const int gw = c * NWAVES + wave, ngw = G * NWAVES;
    for (int it = gw; it < (8 + 128) * 30; it += ngw) {
        const float* src; float* dst;
        if (it < 240) { const int b = it / 30, r = it % 30; src = glu + ((size_t)b * 2048 + 2018 + r) * DM; dst = p->out + O_SA_P + (size_t)it * DM; }
        else { const int e = it - 240, b = e / 30, r = e % 30; src = (r < 26) ? state_a + ((size_t)b * 30 + r + 4) * DM : glu + ((size_t)TP + b * 4 + r - 26) * DM; dst = p->out + O_SA_S + (size_t)e * DM; }
#pragma unroll
        for (int j = 0; j < 4; ++j) ((f32x4*)dst + lane)[64 * j] = ((const f32x4*)src + lane)[64 * j];
    }
}

__device__ __forceinline__ void phase_gate(KP p, const float* z, const float* bg, bf16_t* yb, int gw, int ngw, int lane) {
    const float* state_b = p->in[3]; const float* cw = p->in[15];
    for (int t = gw; t < NTOK; t += ngw) {
        const bool samp = t >= TP; const int b = samp ? ((t - TP) >> 2) : (t >> 11), s = samp ? ((t - TP) & 3) : (t & 2047);
        const float* r2 = z + (size_t)t * DM;
        const float* r1; const float* r0; float f1 = 1.f, f0 = 1.f;
        if (s >= 1) r1 = z + (size_t)(t - 1) * DM; else if (samp) r1 = state_b + ((size_t)b * 2 + 1) * DM; else { r1 = r2; f1 = 0.f; }
        if (s >= 2) r0 = z + (size_t)(t - 2) * DM; else if (samp) r0 = state_b + ((size_t)b * 2 + s) * DM; else { r0 = r2; f0 = 0.f; }
        u32x2* ob = (u32x2*)(yb + (size_t)t * DM) + lane;
        float* st = nullptr;
        if (!samp && s >= 2046) st = p->out + O_SB_P + ((size_t)b * 2 + (s - 2046)) * DM;
        if (samp && s >= 2) st = p->out + O_SB_S + ((size_t)b * 2 + (s - 2)) * DM;
#pragma unroll
        for (int j = 0; j < 4; ++j) {
            const f32x4 z2 = ((const f32x4*)r2 + lane)[64 * j], z1 = ((const f32x4*)r1 + lane)[64 * j] * f1, z0 = ((const f32x4*)r0 + lane)[64 * j] * f0;
            const f32x4 w0 = ((const f32x4*)cw + lane)[64 * j], w1 = ((const f32x4*)(cw + DM) + lane)[64 * j], w2 = ((const f32x4*)(cw + 2 * DM) + lane)[64 * j];
            const f32x4 g = ((const f32x4*)(bg + (size_t)t * DM) + lane)[64 * j];
            const f32x4 y = g * (w0 * z0 + w1 * z1 + w2 * z2);
            u32x2 o; o.x = cvt_pk_bf16(y.x, y.y); o.y = cvt_pk_bf16(y.z, y.w); ob[64 * j] = o;
            if (st) ((f32x4*)st + lane)[64 * j] = z2;
        }
    }
}

__device__ __forceinline__ void phase_vln(KP p, const float* zz, bf16_t* vn, int gw, int ngw, int lane) {
    const float* lg = p->in[18]; const float* lb = p->in[19];
    for (int t = gw; t < NTOK; t += ngw) {
        const f32x4* vr = (const f32x4*)(zz + (size_t)t * 2048 + 1024) + lane; f32x4 v[4]; float s = 0.f;
#pragma unroll
        for (int j = 0; j < 4; ++j) { v[j] = vr[64 * j]; s += (v[j].x + v[j].y) + (v[j].z + v[j].w); }
        const float mean = wave_sum(s) * (1.0f / DM); float s2 = 0.f;
#pragma unroll
        for (int j = 0; j < 4; ++j) { v[j] = v[j] - mean; s2 += (v[j].x * v[j].x + v[j].y * v[j].y) + (v[j].z * v[j].z + v[j].w * v[j].w); }
        const float rstd = 1.0f / sqrtf(wave_sum(s2) * (1.0f / DM) + EPS);
        u32x2* ob = (u32x2*)(vn + (size_t)t * DM) + lane;
#pragma unroll
        for (int j = 0; j < 4; ++j) { const f32x4 g = ((const f32x4*)lg)[lane + 64 * j], bb = ((const f32x4*)lb)[lane + 64 * j]; const f32x4 y = v[j] * rstd * g + bb;
            u32x2 o; o.x = cvt_pk_bf16(y.x, y.y); o.y = cvt_pk_bf16(y.z, y.w); ob[64 * j] = o;
            if (t >= TP) ((f32x4*)(p->out + O_SC_S + (size_t)(t - TP) * DM) + lane)[64 * j] = y; }
    }
}

__device__ __forceinline__ void phase_spatial(KP p, const float* zz, const float* vst, bf16_t* yb, LAS unsigned char* lds, int c, int G, int tid, int wave, int lane) {
    const float* wsp = p->in[20]; const float* bsp = p->in[21];
    constexpr int LD = 136;
    LAS bf16_t* WmL = (LAS bf16_t*)lds; LAS bf16_t* VT = (LAS bf16_t*)(lds + 128 * LD * 2); LAS f32x2* MR = (LAS f32x2*)(lds + 2 * 128 * LD * 2);
    const int hh = c & 7;
    const int cp = tid & 15;
    const f32x4 ga0 = *(const f32x4*)(p->in[18] + hh * 128 + cp * 8), ga1 = *(const f32x4*)(p->in[18] + hh * 128 + cp * 8 + 4);
    const f32x4 ba0 = *(const f32x4*)(p->in[19] + hh * 128 + cp * 8), ba1 = *(const f32x4*)(p->in[19] + hh * 128 + cp * 8 + 4);
    int wm_variant = -1;
    for (int u = c; u < 132 * 8; u += G) {
        const int h = u & 7, cu = u >> 3; const bool samp = cu >= 128; const int tok0 = samp ? TP + (cu - 128) * 128 : cu * 128;
        if (tid < 128) { const f32x4* q = (const f32x4*)(vst + (size_t)(tok0 + tid) * 32); float s1 = 0.f, s2 = 0.f;
#pragma unroll
            for (int k = 0; k < 8; ++k) { const f32x4 w = q[k]; s1 += w.x + w.z; s2 += w.y + w.w; }
            const float mean = s1 * (1.0f / DM), var = s2 * (1.0f / DM) - mean * mean;
            MR[tid] = (f32x2){mean, __builtin_amdgcn_rsqf(fmaxf(var, 0.f) + EPS)}; }
        const int variant = (h << 1) | (samp ? 1 : 0);
        if (variant != wm_variant) {
            f32x2 ww[16];
#pragma unroll
            for (int k = 0; k < 16; ++k) { const int idx = tid + 512 * k, i = idx >> 6, j2 = (idx & 63) * 2;
                ww[k] = *(const f32x2*)(wsp + (size_t)h * 16384 + (samp ? (i & 3) * 128 + (j2 & 3) : i * 128 + j2)); }
#pragma unroll
            for (int k = 0; k < 16; ++k) { const int idx = tid + 512 * k, i = idx >> 6, j2 = (idx & 63) * 2;
                bool k0, k1;
                if (!samp) { k0 = (j2 <= i); k1 = (j2 + 1 <= i); }
                else { const bool same = (i >> 2) == (j2 >> 2); const int ti = i & 3, tj = j2 & 3; k0 = same && tj <= ti; k1 = same && tj + 1 <= ti; }
                *(LAS unsigned*)(WmL + i * LD + j2) = cvt_pk_bf16(k0 ? ww[k].x : 0.f, k1 ? ww[k].y : 0.f); } }
        wm_variant = variant;
        __syncthreads();
#pragma unroll
        for (int k = 0; k < 4; ++k) { const int j = (tid + 512 * k) >> 4;
            const float* vp = zz + (size_t)(tok0 + j) * 2048 + 1024 + h * 128 + cp * 8;
            const f32x4 v0 = *(const f32x4*)vp, v1 = *(const f32x4*)(vp + 4); const f32x2 mr = MR[j];
            const f32x4 y0 = (v0 - mr.x) * mr.y * ga0 + ba0, y1 = (v1 - mr.x) * mr.y * ga1 + ba1;
            if (samp) { float* so = p->out + O_SC_S + (size_t)(tok0 + j - TP) * DM + h * 128 + cp * 8; *(f32x4*)so = y0; *(f32x4*)(so + 4) = y1; }
            const unsigned p0 = cvt_pk_bf16(y0.x, y0.y), p1 = cvt_pk_bf16(y0.z, y0.w), p2 = cvt_pk_bf16(y1.x, y1.y), p3 = cvt_pk_bf16(y1.z, y1.w);
            LAS bf16_t* d = VT + (cp * 8) * LD + j;
            d[0 * LD] = (bf16_t)(p0 & 0xffff); d[1 * LD] = (bf16_t)(p0 >> 16); d[2 * LD] = (bf16_t)(p1 & 0xffff); d[3 * LD] = (bf16_t)(p1 >> 16);
            d[4 * LD] = (bf16_t)(p2 & 0xffff); d[5 * LD] = (bf16_t)(p2 >> 16); d[6 * LD] = (bf16_t)(p3 & 0xffff); d[7 * LD] = (bf16_t)(p3 >> 16); }
        __syncthreads();
        const int i0 = 16 * wave, fr = lane & 15, fq = lane >> 4;
        f32x4 acc[8];
#pragma unroll
        for (int cb = 0; cb < 8; ++cb) acc[cb] = (f32x4){0.f, 0.f, 0.f, 0.f};
        const int nks = (i0 + 15) / 32 + 1;
        for (int ks = 0; ks < nks; ++ks) {
            const bf16x8 wf = *(const LAS bf16x8*)(WmL + (i0 + fr) * LD + ks * 32 + 8 * fq);
#pragma unroll
            for (int cb = 0; cb < 8; ++cb) { const bf16x8 vf = *(const LAS bf16x8*)(VT + (cb * 16 + fr) * LD + ks * 32 + 8 * fq);
                acc[cb] = __builtin_amdgcn_mfma_f32_16x16x32_bf16(vf, wf, acc[cb], 0, 0, 0); }
        }
        const int i = i0 + fr, tok = tok0 + i; const float bsv = bsp[h * 128 + (samp ? (i & 3) : i)];
#pragma unroll
        for (int cb = 0; cb < 8; ++cb) { const int col = h * 128 + cb * 16 + fq * 4;
            const f32x4 uu = *(const f32x4*)(zz + (size_t)tok * 2048 + col); const f32x4 y = uu * (acc[cb] + bsv);
            u32x2 o; o.x = cvt_pk_bf16(y.x, y.y); o.y = cvt_pk_bf16(y.z, y.w); *(u32x2*)(yb + (size_t)tok * DM + col) = o; }
        __syncthreads();
    }
    (void)hh;
}

__device__ __forceinline__ f32x4 bf4_to_f32(u32x2 v) { f32x4 r; r.x = __uint_as_float(v.x << 16); r.y = __uint_as_float(v.x & 0xffff0000u); r.z = __uint_as_float(v.y << 16); r.w = __uint_as_float(v.y & 0xffff0000u); return r; }
__device__ __forceinline__ void pool_token(KP p, const bf16_t* hbn, const float* SS, bf16_t* yb, int t, int lane) {
    const float* state_p = p->in[4];
    const int b = (t - TP) >> 2, s = (t - TP) & 3;
    u32x2* ob = (u32x2*)(yb + (size_t)t * DM) + lane;
    float rsd[4];
#pragma unroll
    for (int d = 0; d < 4; ++d) rsd[d] = (d <= s) ? pg8::row_rs(SS, t - (d <= s ? d : 0)) : 0.f;
#pragma unroll
    for (int j = 0; j < 4; ++j) {
        const int w = 2 << j; const f32x4 x0 = bf4_to_f32(((const u32x2*)(hbn + (size_t)t * DM) + lane)[64 * j]) * rsd[0]; f32x4 sum = x0;
#pragma unroll
        for (int d = 1; d < w; ++d) {
            if (d < 4) sum += bf4_to_f32(((const u32x2*)(hbn + (size_t)(t - (d <= s ? d : 0)) * DM) + lane)[64 * j]) * rsd[d];
            const int si = 15 + s - d;
            sum += ((const f32x4*)(state_p + ((size_t)b * 15 + (si > 14 ? 14 : si)) * DM) + lane)[64 * j] * ((d > s) ? 1.0f : 0.0f);
        }
        const f32x4 y = sum * (1.0f / (float)w) - x0;
        u32x2 o; o.x = cvt_pk_bf16(y.x, y.y); o.y = cvt_pk_bf16(y.z, y.w); ob[64 * j] = o;
    }
}
__device__ __forceinline__ void pool_state_rows(KP p, const bf16_t* hbn, const float* SS, int gw, int ngw, int lane) {
    const float* state_p = p->in[4];
    for (int it = gw; it < (8 + 128) * 15; it += ngw) {
        const float* src = nullptr; int tt = 0; float* dst;
        if (it < 120) { const int b = it / 15, r = it % 15; tt = b * 2048 + 2033 + r; dst = p->out + O_SP_P + (size_t)it * DM; }
        else { const int e = it - 120, b = e / 15, r = e % 15; if (r < 11) src = state_p + ((size_t)b * 15 + r + 4) * DM; else tt = TP + b * 4 + r - 11; dst = p->out + O_SP_S + (size_t)e * DM; }
        if (src) {
#pragma unroll
            for (int j = 0; j < 4; ++j) ((f32x4*)dst + lane)[64 * j] = ((const f32x4*)src + lane)[64 * j];
        } else { const float rs = pg8::row_rs(SS, tt);
#pragma unroll
            for (int j = 0; j < 4; ++j) ((f32x4*)dst + lane)[64 * j] = bf4_to_f32(((const u32x2*)(hbn + (size_t)tt * DM) + lane)[64 * j]) * rs; }
    }
}
__device__ __forceinline__ void pool_tile_prompt(const bf16_t* hbn, const float* SS, bf16_t* yb, LAS unsigned char* lds, int pm, int g, int tid) {
    LAS float* RS = (LAS float*)lds;
    const int t0 = pm * 256, sbase = (pm & 7) * 256;
    for (int k = tid; k < 271; k += NTHREADS) RS[k] = (sbase - 15 + k >= 0) ? pg8::row_rs(SS, t0 - 15 + k) : 0.f;
    __syncthreads();
    const int w = 2 << g, r0 = (tid >> 5) * 16; const size_t colb = (size_t)g * 256 + (tid & 31) * 8;
    f32x4 sa = (f32x4){0.f, 0.f, 0.f, 0.f}, sb = sa;
#define POOL_LDX(r_, a_, b_) do { const u32x4 v_ = *(const u32x4*)(hbn + (size_t)(t0 + (r_)) * DM + colb); const float rs_ = RS[(r_) + 15]; \
        a_ = bf4_to_f32((u32x2){v_.x, v_.y}) * rs_; b_ = bf4_to_f32((u32x2){v_.z, v_.w}) * rs_; } while (0)
    for (int d = 1; d < w; ++d) { const int r = r0 - d; if (sbase + r >= 0) { f32x4 a, b; POOL_LDX(r, a, b); sa += a; sb += b; } }
    for (int i = 0; i < 16; ++i) { const int r = r0 + i, s = sbase + r; f32x4 a, b; POOL_LDX(r, a, b); sa += a; sb += b;
        const float inv = 1.0f / (float)((s + 1 < w) ? s + 1 : w);
        const f32x4 ya = sa * inv - a, yc = sb * inv - b;
        u32x4 o; o.x = cvt_pk_bf16(ya.x, ya.y); o.y = cvt_pk_bf16(ya.z, ya.w); o.z = cvt_pk_bf16(yc.x, yc.y); o.w = cvt_pk_bf16(yc.z, yc.w);
        *(u32x4*)(yb + (size_t)(t0 + r) * DM + colb) = o;
        const int ro = r - w + 1; if (sbase + ro >= 0) { f32x4 a2, b2; POOL_LDX(ro, a2, b2); sa -= a2; sb -= b2; } }
#undef POOL_LDX
}

__global__ void __launch_bounds__(NTHREADS, 2) mega_fwd(Params p_unused) {
    extern __shared__ __attribute__((aligned(16))) unsigned char shm[];
    LAS unsigned char* lds = (LAS unsigned char*)shm;
    cg::grid_group grid = cg::this_grid();
    volatile LAS unsigned* st = (volatile LAS unsigned*)(lds + 131072);
    if (threadIdx.x == 0) { st[0] = 0u; st[1] = 0u; st[2] = 0u; st[3] = 0u; }
    __syncthreads();
    XcdBarrier bar;
#ifdef PROBE_CLASS
    unsigned long long pr_acc = 0, pr_t0 = __builtin_amdgcn_s_memrealtime();
#define PR_BEGIN() pr_t0 = __builtin_amdgcn_s_memrealtime()
#define PR_END(cond) do { if (cond) pr_acc += __builtin_amdgcn_s_memrealtime() - pr_t0; } while (0)
#else
#define PR_BEGIN()
#define PR_END(cond)
#endif
    {
        KP p = (KP)__builtin_amdgcn_kernarg_segment_ptr();
        const int tid = threadIdx.x, lane = tid & 63, wave = __builtin_amdgcn_readfirstlane(tid >> 6);
        const int G = gridDim.x, c = blockIdx.x, gw = c * NWAVES + wave, ngw = G * NWAVES;
        bar = xcd_barrier_post((unsigned*)(p->ws + WS_BAR), st);
        phase_prologue(p, lds, gw, ngw, wave, lane);
    }
    grid.sync();
    PR_END(PROBE_CLASS == 0);

#pragma unroll 1
    for (int ph = 0; ph < NLAYER * 11; ++ph) {
        KP p = (KP)__builtin_amdgcn_kernarg_segment_ptr(); asm volatile("" : "+s"(p));
        int G = gridDim.x, c = blockIdx.x; asm volatile("" : "+s"(G), "+s"(c));
#define PHASE_IDS() int tid = threadIdx.x; asm volatile("" : "+v"(tid)); const int lane = tid & 63, wave = __builtin_amdgcn_readfirstlane(tid >> 6), gw = c * NWAVES + wave, ngw = G * NWAVES; (void)lane; (void)wave; (void)gw; (void)ngw
        unsigned char* ws = p->ws;
        const int layer = ph / 11, step = ph % 11;
        float* h = p->out + O_Y;
        bf16_t* hb = (bf16_t*)(ws + WS_HB);
        bf16_t* act = (bf16_t*)(ws + WS_ACT);
        bf16_t* yb = (bf16_t*)(ws + WS_ACT);
        bf16_t* vn = (bf16_t*)(ws + WS_ACT + (size_t)NTOK * DM * 2);
        float* F = (float*)(ws + WS_F);
        float* FX = (float*)(ws + WS_FX);
        float* MT = (float*)(ws + WS_MT);
        float* SS = (float*)(ws + WS_SS);
        const float* g6 = p->in[5] + (size_t)layer * 6 * DM;
        int kind;
        switch (step) {
            case 0: case 8: kind = 1; break;
            case 1: case 9: case 6: kind = 9; break;
            case 2: case 7: case 10: kind = 0; break;
            case 3: kind = (layer == 0 || layer == 1) ? 1 : (layer == 2 ? 2 : 0); break;
            case 4: kind = (layer == 0) ? 4 : 0; break;
            default: kind = (layer == 1) ? 5 : (layer == 2 ? 7 : 0); break;
        }
        if (kind == 0) continue;
        PR_BEGIN();
        const int rstep = (step == 2 || step == 7 || step == 10) ? step - 1 : step;
        const float* gA = g6 + (rstep == 1 ? 1 : (rstep == 6 ? 3 : 5)) * DM;
        const float* gB = g6 + (rstep == 1 ? 2 : (rstep == 6 ? 4 : 6)) * DM;
        const float rscale = (rstep == 6) ? 1.0f : 0.5f;
        const int rlast = (layer == 3 && rstep == 9) ? 1 : 0;
        const int rns = (rstep == 6) ? ((layer == 3) ? 1 : 4) : 11;
        if (kind == 1) {
            pg8::Sched S; S.A = (const char*)hb; S.lda = DM; S.ldb = DM; S.K = DM; S.ns = 0; S.apn = 0; S.G = G; S.c = c; S.smode = 0;
            pg8::EpiGated E; E.SS = SS; E.pn_plain = 1 << 20; E.OF2 = nullptr; E.pub = nullptr;
            unsigned* pubcnt = (unsigned*)(ws + WS_CNT) + 48;
            if (step != 3) { S.Bt = (const char*)(ws + WS_W_FFN_IN + (size_t)(layer * 2 + (step == 8 ? 1 : 0)) * SZ_FFN_IN); S.nN = 22; E.O = act; E.OF = nullptr; E.ldo = DFF; E.mode = 0; S.smode = 1; E.pub = pubcnt; }
            else { S.Bt = (const char*)(ws + (layer == 0 ? WS_W_A_IN : WS_W_B_IN)); S.nN = 8; E.O = nullptr; E.OF = MT; E.ldo = DM; E.mode = (layer == 0) ? 1 : 2;
                if (layer == 1) { S.nN = 12; E.pn_plain = 8; E.OF2 = MT + (size_t)NTOK * DM; } }
#ifdef PROBE_CLASS
            pg8::gemm_phase(lds, S, E, (PROBE_CLASS == 6 && step != 3) ? (unsigned long long*)(ws + WS_BAR + 15360) : nullptr);
#else
            pg8::gemm_phase(lds, S, E);
#endif
            if (step == 3) { const int nextra = 66 * S.nN - 2 * 256 - (layer == 1 ? 256 : 0);
                if (c >= nextra) { PHASE_IDS(); convert_ffn_in_layer(p, layer + 1, lds, (c - nextra) * NWAVES + wave, (G - nextra) * NWAVES, wave, lane);
                    convert_mixer_weights(p, layer + 1, lds, (c - nextra) * NWAVES + wave, (G - nextra) * NWAVES, wave, lane);
                    if (layer == 0) { LAS float* scr = (LAS float*)(lds + wave * 16384); const int gwx = (c - nextra) * NWAVES + wave, ngwx = (G - nextra) * NWAVES;
                        for (int it = gwx; it < 16 * 176; it += ngwx) convert_matrix(p->in[6] + (size_t)1 * DM * 2 * DFF, DM, 2 * DFF, DFF, (bf16_t*)(ws + WS_W_FFN_IN + 1 * SZ_FFN_IN), it, scr, lane);
                        for (int it = gwx; it < 44 * 32; it += ngwx) convert_matrix(p->in[7] + (size_t)1 * DFF * DM, DFF, DM, 0, (bf16_t*)(ws + WS_W_FFN_DN + 1 * SZ_FFN_DN), it, scr, lane);
                        for (int it = gwx; it < 16 * 32; it += ngwx) convert_matrix(p->in[13], DM, DM, 0, (bf16_t*)(ws + WS_W_A_OUT), it, scr, lane); } } }
            if (step != 3 && c >= 172) {
                PHASE_IDS();
                if (tid == 0) { const unsigned want = 44u * (unsigned)(layer * 2 + (step == 8 ? 2 : 1)); unsigned sp = 0;
                    while (__hip_atomic_load(pubcnt, __ATOMIC_RELAXED, __HIP_MEMORY_SCOPE_AGENT) < want) { __builtin_amdgcn_s_sleep(1); if (++sp > (1u << 22)) break; }
                    __builtin_amdgcn_fence(__ATOMIC_ACQUIRE, "agent"); asm volatile("s_waitcnt vmcnt(0)" ::: "memory"); }
                __syncthreads();
                pg8::Sched S2; S2.A = (const char*)act; S2.Bt = (const char*)(ws + WS_W_FFN_DN + (size_t)(layer * 2 + (step == 8 ? 1 : 0)) * SZ_FFN_DN); S2.lda = DFF; S2.ldb = DFF; S2.nN = 4; S2.K = DFF; S2.ns = 11; S2.apn = 0;
                S2.G = 84; S2.c = c - 172; S2.smode = 3;
                pg8::EpiSlab E2; E2.F = F; E2.FX = FX; E2.SS = nullptr;
                pg8::gemm_phase(lds, S2, E2);
                if (ph == 0) { LAS float* scr = (LAS float*)(lds + wave * 16384);
                    for (int it = (c - 172) * NWAVES + wave; it < 16 * 64; it += 84 * NWAVES) convert_matrix(p->in[8], DM, 2048, 1024, (bf16_t*)(ws + WS_W_A_IN), it, scr, lane); }
                if (layer < 3) {
                    const int m = 2 * (layer + 1) + (step == 8 ? 1 : 0); LAS float* scr = (LAS float*)(lds + wave * 16384);
                    for (int it = (c - 172) * NWAVES + wave; it < 1344; it += 84 * NWAVES)
                        convert_matrix(p->in[7] + (size_t)m * DFF * DM, DFF, DM, 0, (bf16_t*)(ws + WS_W_FFN_DN + m * SZ_FFN_DN), it, scr, lane);
                }
            }
        } else if (kind == 2) {
            pg8::Sched S; S.G = G; S.c = c; S.apn = 0; S.ns = 0; S.A = (const char*)hb; S.lda = DM; S.ldb = DM; S.K = DM; S.smode = 0;
            pg8::EpiF32 E; E.SS = SS; E.vst = nullptr;
            if (step == 3) { S.Bt = (const char*)(ws + WS_W_C_IN); S.nN = 8; E.C = MT; E.ldc = 2048; E.act = 1; E.vst = (float*)vn; }
            else { S.Bt = (const char*)(ws + WS_W_B_IN + (size_t)2048 * DM * 2); S.nN = 4; E.C = MT + (size_t)NTOK * DM; E.ldc = DM; E.act = 0; }
            pg8::gemm_phase(lds, S, E);
            if (step == 3 && c >= 16) { PHASE_IDS(); convert_ffn_in_layer(p, layer + 1, lds, (c - 16) * NWAVES + wave, (G - 16) * NWAVES, wave, lane);
                convert_mixer_weights(p, layer + 1, lds, (c - 16) * NWAVES + wave, (G - 16) * NWAVES, wave, lane); }
        } else if (kind == 9) {
            pg8::Sched S; S.G = G; S.c = c; S.apn = 0; S.nN = 4; S.smode = (step != 6) ? 2 : 0;
            pg8::EpiResNorm E; E.h = h; E.hsrc = (ph == 1) ? p->in[0] : h; E.hb = hb; E.SS = SS; E.F = F; E.FX = FX; E.gA = gA; E.gB = gB; E.cscale = nullptr; E.scale = rscale; E.last = rlast;
            E.xbuf = (float*)(ws + WS_XBUF); E.cnt = (unsigned*)(ws + WS_CNT); E.tab = (LAS float*)(lds + LDS_TAB);
            E.target = 32u * (unsigned)(layer * 3 + (step == 1 ? 1 : (step == 6 ? 2 : 3)));
            if (step != 6) { S.A = (const char*)act; S.Bt = (const char*)(ws + WS_W_FFN_DN + (size_t)(layer * 2 + (step == 9 ? 1 : 0)) * SZ_FFN_DN); S.lda = DFF; S.ldb = DFF; S.K = DFF; S.ns = 11; }
            else { S.A = (const char*)(layer == 3 ? (bf16_t*)MT : yb); S.lda = DM;
                if (layer == 3) { S.Bt = (const char*)(ws + WS_W_D); S.ldb = 256; S.K = 256; S.ns = 1; S.apn = 256; E.cscale = p->in[24];
                    PHASE_IDS(); int pm0, pn0; pg8::map_tile(c, 64, 4, pm0, pn0);
                    pool_tile_prompt(hb, SS, (bf16_t*)MT, lds, pm0, pn0, tid);
                    pool_state_rows(p, hb, SS, gw, ngw, lane);
                    asm volatile("s_waitcnt vmcnt(0)" ::: "memory"); __syncthreads(); }
                else { S.Bt = (const char*)(ws + (layer == 0 ? WS_W_A_OUT : (layer == 1 ? WS_W_B_OUT : WS_W_C_OUT))); S.ldb = DM; S.K = DM; S.ns = 4; } }
#ifdef PROBE_CLASS
            pg8::gemm_phase(lds, S, E, (PROBE_CLASS == 7 && step != 6) ? (unsigned long long*)(ws + WS_BAR + 15360) : nullptr);
#else
            pg8::gemm_phase(lds, S, E);
#endif
            {
                PHASE_IDS();
                unsigned* cs = (unsigned*)(ws + WS_CNT) + 32;
                const unsigned starget = 32u * (unsigned)layer + (layer == 3 ? 8u : 32u);
                asm volatile("s_waitcnt vmcnt(0)" ::: "memory");
                __syncthreads();
                if (step == 6 && c < 8 * S.ns && tid == 0) { __builtin_amdgcn_fence(__ATOMIC_RELEASE, "agent"); asm volatile("s_waitcnt vmcnt(0)" ::: "memory"); __hip_atomic_fetch_add(cs, 1u, __ATOMIC_RELAXED, __HIP_MEMORY_SCOPE_AGENT); }
                if (c < 64) {
                    if (step == 6 && tid == 0) { unsigned sp = 0; while (__hip_atomic_load(cs, __ATOMIC_RELAXED, __HIP_MEMORY_SCOPE_AGENT) < starget) { __builtin_amdgcn_s_sleep(1); if (++sp > (1u << 22)) break; }
                        __builtin_amdgcn_fence(__ATOMIC_ACQUIRE, "agent"); asm volatile("s_waitcnt vmcnt(0)" ::: "memory"); }
                    __syncthreads();
                    phase_resnorm_sample(h, (ph == 1) ? p->in[1] - (size_t)TP * DM : h, F, FX, rns, rscale, gA, gB, hb, SS, rlast, gw, 512, lane);
                    if (layer == 3 && step == 1) {
                        asm volatile("s_waitcnt vmcnt(0)" ::: "memory"); __syncthreads();
                        pool_token(p, hb, SS, (bf16_t*)MT, TP + gw, lane);
                    }
                }
            }
        } else if (kind == 4) { PHASE_IDS(); phase_conv(p, MT, yb, lds, c, G, wave, lane); }
        else if (kind == 5) { PHASE_IDS(); phase_gate(p, MT, MT + (size_t)NTOK * DM, yb, gw, ngw, lane); }
        else if (kind == 7) { PHASE_IDS(); phase_spatial(p, MT, (const float*)vn, yb, lds, c, G, tid, wave, lane); }
        else { }
        PR_END((PROBE_CLASS == 1 && kind == 1 && step != 3) || (PROBE_CLASS == 2 && kind == 9 && step != 6) || (PROBE_CLASS == 4 && step >= 3 && step <= 6) || (PROBE_CLASS == 5 && kind == 3));
        PR_BEGIN();
        if (ph != NLAYER * 11 - 1) xcd_barrier(bar);
        PR_END(PROBE_CLASS == 3 || (PROBE_CLASS == 4 && step >= 3 && step <= 6));
    }
#ifdef PROBE_CLASS
    if (PROBE_CLASS >= 6) { pr_acc = *(volatile unsigned long long*)(((KP)__builtin_amdgcn_kernarg_segment_ptr())->ws + WS_BAR + 15360); }
    if (blockIdx.x == 0) { const unsigned long long t0 = __builtin_amdgcn_s_memrealtime(); while (__builtin_amdgcn_s_memrealtime() - t0 < pr_acc) __builtin_amdgcn_s_sleep(8); }
#endif
}

extern "C" void kernel_launch(void* const* d_in, const int* in_sizes, int n_in, void* d_out, int out_size, void* d_ws, size_t ws_size, hipStream_t stream) {
    static int grid = 0;
    if (grid == 0) {
        if (n_in != 25 || (size_t)out_size != O_END || ws_size < WS_END) { fprintf(stderr, "kernel_launch: unexpected shapes (n_in %d out %d ws %zu need %zu)\n", n_in, out_size, ws_size, (size_t)WS_END); grid = -1; return; }
        int dev = 0, cus = 0, per_cu = 0;
        hipGetDevice(&dev); hipDeviceGetAttribute(&cus, hipDeviceAttributeMultiprocessorCount, dev);
        hipFuncSetAttribute((const void*)mega_fwd, hipFuncAttributeMaxDynamicSharedMemorySize, LDS_BYTES);
        hipOccupancyMaxActiveBlocksPerMultiprocessor(&per_cu, (const void*)mega_fwd, NTHREADS, LDS_BYTES);
        if (per_cu < 1) { fprintf(stderr, "kernel_launch: occupancy query says %d blocks per CU\n", per_cu); per_cu = 1; }
        (void)hipGetLastError();
        grid = cus;
        if (grid != 256) fprintf(stderr, "kernel_launch: the fused epilogues assume 256 workgroups (got %d CUs)\n", grid);
    }
    if (grid < 0) return;
    hipMemsetAsync((char*)d_ws + WS_BAR, 0, 32768, stream);
    Params p{};
    for (int i = 0; i < 25; ++i) p.in[i] = (const float*)d_in[i];
    p.out = (float*)d_out; p.ws = (unsigned char*)d_ws;
    void* args[] = {&p};
    hipError_t e = hipLaunchCooperativeKernel((const void*)mega_fwd, dim3(grid), dim3(NTHREADS), args, LDS_BYTES, stream);
    if (e != hipSuccess) fprintf(stderr, "cooperative launch failed: %s (grid %d)\n", hipGetErrorString(e), grid);
}
```

```cpp
#include <hip/hip_runtime.h>
#include <hip/hip_cooperative_groups.h>
#include <cstdio>
#include <cstdint>
namespace cg = cooperative_groups;


#define LAS __attribute__((address_space(3)))
typedef unsigned short bf16_t;
typedef short bf16x8 __attribute__((ext_vector_type(8)));
typedef float f32x4 __attribute__((ext_vector_type(4)));
typedef float f32x2 __attribute__((ext_vector_type(2)));
typedef unsigned u32x4 __attribute__((ext_vector_type(4)));
typedef unsigned u32x2 __attribute__((ext_vector_type(2)));

constexpr int DM = 1024, DFF = 2816, TP = 16384, TS = 512, NTOK = TP + TS, NLAYER = 4;
constexpr float EPS = 1e-6f;
constexpr int NTHREADS = 512, NWAVES = 8;

constexpr size_t O_Y = 0;
constexpr size_t O_SA_P = (size_t)NTOK * DM;
constexpr size_t O_SA_S = O_SA_P + (size_t)8 * 30 * DM;
constexpr size_t O_SB_P = O_SA_S + (size_t)128 * 30 * DM;
constexpr size_t O_SB_S = O_SB_P + (size_t)8 * 2 * DM;
constexpr size_t O_SC_S = O_SB_S + (size_t)128 * 2 * DM;
constexpr size_t O_SP_P = O_SC_S + (size_t)128 * 4 * DM;
constexpr size_t O_SP_S = O_SP_P + (size_t)8 * 15 * DM;
constexpr size_t O_END = O_SP_S + (size_t)128 * 15 * DM;

constexpr size_t WS_BAR = 0;
constexpr size_t WS_CNT = 16384;
constexpr size_t WS_XBUF = 32768;
constexpr size_t WS_SS = WS_XBUF + (size_t)64 * 256 * 4 * 4;
constexpr size_t WS_W_FFN_IN = WS_SS + (size_t)NTOK * 4 * 4;
constexpr size_t SZ_FFN_IN = (size_t)2 * DFF * DM * 2;
constexpr size_t WS_W_FFN_DN = WS_W_FFN_IN + 8 * SZ_FFN_IN;
constexpr size_t SZ_FFN_DN = (size_t)DM * DFF * 2;
constexpr size_t WS_W_A_IN = WS_W_FFN_DN + 8 * SZ_FFN_DN;
constexpr size_t WS_W_A_OUT = WS_W_A_IN + (size_t)2048 * 1024 * 2;
constexpr size_t WS_W_B_IN = WS_W_A_OUT + (size_t)1024 * 1024 * 2;
constexpr size_t WS_W_B_OUT = WS_W_B_IN + (size_t)3072 * 1024 * 2;
constexpr size_t WS_W_C_IN = WS_W_B_OUT + (size_t)1024 * 1024 * 2;
constexpr size_t WS_W_C_OUT = WS_W_C_IN + (size_t)2048 * 1024 * 2;
constexpr size_t WS_W_D = WS_W_C_OUT + (size_t)1024 * 1024 * 2;
constexpr size_t WS_HB = WS_W_D + (size_t)1024 * 256 * 2;
constexpr size_t WS_ACT = WS_HB + (size_t)NTOK * DM * 2;
constexpr size_t WS_F = WS_ACT + (size_t)NTOK * DFF * 2;
constexpr size_t WS_FX = WS_F + (size_t)NTOK * DM * 4;
constexpr size_t WS_MT = WS_FX + (size_t)10 * TS * DM * 4;
constexpr size_t WS_END = WS_MT + (size_t)NTOK * 3072 * 4;

constexpr int LDS_TAB = 131072 + 64;
constexpr int LDS_BYTES = LDS_TAB + 5120 + 64;

struct Params { const float* in[25]; float* out; unsigned char* ws; };
typedef const Params __attribute__((address_space(4)))* KP;

__device__ __forceinline__ unsigned cvt_pk_bf16(float lo, float hi) { unsigned r; asm volatile("v_cvt_pk_bf16_f32 %0, %1, %2" : "=v"(r) : "v"(lo), "v"(hi)); return r; }
__device__ __forceinline__ float wave_sum(float v) {
#pragma unroll
    for (int o = 1; o < 64; o <<= 1) v += __shfl_xor(v, o);
    return v;
}
__device__ __forceinline__ float sigmoid_f(float x) { return __builtin_amdgcn_rcpf(1.0f + __expf(-x)); }
__device__ __forceinline__ f32x2 gelu_pk(f32x2 v) {
    const f32x2 av = __builtin_elementwise_abs(v), d = av * 0.2316418882f + 1.0f;
    f32x2 t; t.x = __builtin_amdgcn_rcpf(d.x); t.y = __builtin_amdgcn_rcpf(d.y);
    f32x2 q = t * 0.5307027145f + (-0.7265760135f); q = q * t + 0.7107068705f; q = q * t + (-0.142248368f); q = q * t + 0.127414796f; q = q * t;
    const f32x2 s = (v * v) * (-0.72134752044f);
    f32x2 e; e.x = __builtin_amdgcn_exp2f(s.x); e.y = __builtin_amdgcn_exp2f(s.y);
    const f32x2 m = v * (q * e), r = v - m;
    f32x2 o; o.x = v.x < 0.f ? m.x : r.x; o.y = v.y < 0.f ? m.y : r.y; return o;
}

#define XB_TMO      128
#define XB_XCNT(j)  (256  + 64 * (j))
#define XB_XSUB(j)  (1280 + 64 * (j))
#define XB_XGEN(j)  (2304 + 64 * (j))
#define XB_TOP      3328
#define XB_TOPGEN   3392
#define XCD_BAR_WORDS 3456
#define XB_SPIN_CAP (1u << 20)
__device__ __forceinline__ unsigned xb_ld(unsigned* p)              { return __hip_atomic_load(p, __ATOMIC_RELAXED, __HIP_MEMORY_SCOPE_AGENT); }
__device__ __forceinline__ unsigned xb_add(unsigned* p, unsigned v) { return __hip_atomic_fetch_add(p, v, __ATOMIC_RELAXED, __HIP_MEMORY_SCOPE_AGENT); }
__device__ __forceinline__ unsigned xb_xcc_id() { return (unsigned)__builtin_amdgcn_s_getreg((3 << 11) | 20) & 0xFu; }
#define XB_SPIN(cond, bar) do { unsigned _sp = 0; while (cond) { __builtin_amdgcn_s_sleep(1); \
    if ((++_sp & 255u) == 0u) { if (xb_ld(&(bar)[XB_TMO])) break; if (_sp > XB_SPIN_CAP) { atomicAdd(&(bar)[XB_TMO], 1u); break; } } } } while (0)
struct XcdBarrier { unsigned* bar; unsigned x; volatile LAS unsigned* st; };
__device__ __forceinline__ XcdBarrier xcd_barrier_post(unsigned* bar, volatile LAS unsigned* st) {
    XcdBarrier b; b.bar = bar; b.x = xb_xcc_id(); b.st = st;
    if (threadIdx.x == 0) (void)xb_add(&bar[XB_XCNT(b.x)], 1u);
    return b;
}
__device__ __forceinline__ void xcd_barrier_complete(unsigned* bar, unsigned x, unsigned& nloc, unsigned& nx) {
    const unsigned G = gridDim.x * gridDim.y * gridDim.z;
    unsigned sum, cnt, mine, sp = 0u;
    for (;;) {
        sum = 0u; cnt = 0u; mine = 0u;
#pragma unroll
        for (unsigned j = 0; j < 16; ++j) { const unsigned c = xb_ld(&bar[XB_XCNT(j)]); sum += c; cnt += (c > 0u) ? 1u : 0u; mine = (j == x) ? c : mine; }
        if (sum == G) break;
        __builtin_amdgcn_s_sleep(1);
        if ((++sp & 255u) == 0u) { if (xb_ld(&bar[XB_TMO])) break; if (sp > XB_SPIN_CAP) { atomicAdd(&bar[XB_TMO], 1u); break; } }
    }
    nloc = mine > 0u ? mine : 1u; nx = cnt > 0u ? cnt : 1u;
}
__device__ __forceinline__ void xcd_barrier(const XcdBarrier& b) {
    asm volatile("s_waitcnt vmcnt(0)" ::: "memory");
    __syncthreads();
    if (threadIdx.x == 0) {
        unsigned* bar = b.bar;
        __builtin_amdgcn_s_waitcnt(0);
        unsigned nloc = b.st[0], nx = b.st[1];
        if (nloc == 0u) { xcd_barrier_complete(bar, b.x, nloc, nx); b.st[0] = nloc; b.st[1] = nx; }
        const unsigned old = xb_add(&bar[XB_XSUB(b.x)], 1u);
        const unsigned gen = old / nloc;
        if (old + 1u == (gen + 1u) * nloc) {
            __builtin_amdgcn_fence(__ATOMIC_RELEASE, "agent");
            asm volatile("s_waitcnt vmcnt(0)" ::: "memory");
            const unsigned og = xb_add(&bar[XB_TOP], 1u);
            const unsigned tg = og / nx;
            if (og + 1u == (tg + 1u) * nx) xb_add(&bar[XB_TOPGEN], 1u);
            else XB_SPIN(xb_ld(&bar[XB_TOPGEN]) == tg, bar);
            __builtin_amdgcn_fence(__ATOMIC_ACQUIRE, "agent");
            xb_add(&bar[XB_XGEN(b.x)], 1u);
            asm volatile("s_waitcnt vmcnt(0)" ::: "memory");
        } else {
            XB_SPIN(xb_ld(&bar[XB_XGEN(b.x)]) == gen, bar);
            __builtin_amdgcn_fence(__ATOMIC_ACQUIRE, "agent");
            asm volatile("s_waitcnt vmcnt(0)" ::: "memory");
        }
    }
    __syncthreads();
}

namespace pg8 {
constexpr int BM = 256, BK = 64, HALF = 128, HTB = HALF * BK * 2, STAGE_BYTES = 8 * HTB, NXCD = 8, WGM = 8;
__device__ __forceinline__ int lds_byte(int r, int c) { const int st = (r >> 4) * 2 + (c >> 5), rr = r & 15, cc = c & 31, ob = rr * 64 + cc * 2; return st * 1024 + (ob ^ (((ob >> 9) & 1) << 5)); }
__device__ __forceinline__ void stage_rc(int b, int& R, int& C) { const int st = b / 1024, sb = b % 1024, swz = sb ^ (((sb >> 9) & 1) << 5); R = (st >> 1) * 16 + swz / 64; C = (st & 1) * 32 + (swz % 64) / 2; }
__device__ __forceinline__ int perm32(int rho) { const int n = rho >> 4, i = rho & 15; return 8 * (i >> 2) + 4 * n + (i & 3); }

struct Unit { const char* a; const char* b; int pm, pn, z, nt; };

__device__ __forceinline__ void map_tile(int L, int nM, int nN, int& pm, int& pn) {
    const int nwg = nM * nN; int wgid = L;
    { const int q = nwg / NXCD, r = nwg % NXCD, xcd = wgid % NXCD, off = wgid / NXCD; wgid = (xcd < r ? xcd * (q + 1) : r * (q + 1) + (xcd - r) * q) + off; }
    const int nig = WGM * nN, gid = wgid / nig, fm = gid * WGM, gsz = (nM - fm) < WGM ? (nM - fm) : WGM;
    pm = fm + ((wgid % nig) % gsz); pn = (wgid % nig) / gsz;
}

struct Sched {
    const char* A; const char* Bt; int lda, ldb, nN, K, ns, apn, G, c, smode;
    __device__ __forceinline__ bool next(int i, Unit& u) const {
        const int L = i * G + c; int pm, pn, z = 0, nt;
        if (smode == 1) { if (L >= 66 * nN) return false; if (L < 2 * nN) { pm = 64 + (L & 1); pn = L >> 1; } else map_tile(L - 2 * nN, 64, nN, pm, pn); nt = K >> 6; }
        else if (smode == 2) { if (L >= 64 * nN) return false; map_tile(L, 64, nN, pm, pn); nt = K >> 6; }
        else if (smode == 3) { if (L >= 2 * nN * ns) return false; z = L / (2 * nN); const int r = L % (2 * nN); pm = 64 + r / nN; pn = r % nN; nt = (K / ns) >> 6; }
        else if (ns == 0) { if (L >= 66 * nN) return false; map_tile(L, 66, nN, pm, pn); nt = K >> 6; }
        else if (L < 64 * nN) { map_tile(L, 64, nN, pm, pn); nt = K >> 6; }
        else { const int e = L - 64 * nN; if (e >= 2 * nN * ns) return false; z = e / (2 * nN); const int r = e % (2 * nN); pm = 64 + r / nN; pn = r % nN; nt = (K / ns) >> 6; }
        const int ksub = nt * 64;
        u.a = A + ((size_t)pm * 256 * lda + (size_t)pn * apn + (size_t)z * ksub) * 2;
        u.b = Bt + ((size_t)pn * 256 * ldb + (size_t)z * ksub) * 2;
        u.pm = pm; u.pn = pn; u.z = z; u.nt = nt; return true;
    }
};

__device__ __forceinline__ float row_rs(const float* SS, int row) { const f32x4 q = *(const f32x4*)(SS + (size_t)row * 4); return __builtin_amdgcn_rsqf(((q.x + q.y) + (q.z + q.w)) * (1.0f / DM) + EPS); }

struct EpiF32 {
    static constexpr bool PERM = false;
    static constexpr bool USE_RS = true;
    float* C; int ldc; int act; const float* SS; float* vst;
    __device__ __forceinline__ void operator()(f32x4 (&acc)[2][2][4][2], const Unit& u, int wr, int wc, int fr, int fq, const LAS float* rstab) const {
        const int row0 = u.pm * BM + wr * 64 + fr, col0 = u.pn * BM + wc * 32 + 4 * fq;
        const bool stats = (vst != nullptr) && (u.pn >= 4);
        float rsv[2][4];
#pragma unroll
        for (int ai = 0; ai < 2; ++ai)
#pragma unroll
            for (int m = 0; m < 4; ++m) rsv[ai][m] = rstab[ai * HALF + wr * 64 + m * 16 + fr];
#pragma unroll
        for (int ai = 0; ai < 2; ++ai)
#pragma unroll
            for (int m = 0; m < 4; ++m) { const int row = row0 + ai * HALF + m * 16; const float rs = rsv[ai][m]; float* rowp = C + (size_t)row * ldc + col0; float s1 = 0.f, s2 = 0.f;
#pragma unroll
                for (int bj = 0; bj < 2; ++bj)
#pragma unroll
                    for (int n = 0; n < 2; ++n) { f32x4 v = acc[ai][bj][m][n] * rs;
                        if (act) { const f32x2 a = gelu_pk((f32x2){v[0], v[1]}), b = gelu_pk((f32x2){v[2], v[3]}); v = (f32x4){a.x, a.y, b.x, b.y}; }
                        s1 += (v[0] + v[1]) + (v[2] + v[3]); s2 += (v[0] * v[0] + v[1] * v[1]) + (v[2] * v[2] + v[3] * v[3]);
                        *(f32x4*)(rowp + bj * HALF + n * 16) = v; }
                if (stats) { s1 += __shfl_xor(s1, 16); s1 += __shfl_xor(s1, 32); s2 += __shfl_xor(s2, 16); s2 += __shfl_xor(s2, 32);
                    if (fq == 0) *(f32x2*)(vst + ((size_t)row * 16 + (u.pn - 4) * 4 + wc) * 2) = (f32x2){s1, s2}; } }
    }
};
struct EpiGated {
    static constexpr bool PERM = true;
    static constexpr bool USE_RS = true;
    bf16_t* O; float* OF; int ldo; int mode; const float* SS; int pn_plain; float* OF2; unsigned* pub;
    __device__ __forceinline__ void operator()(f32x4 (&acc)[2][2][4][2], const Unit& u, int wr, int wc, int fr, int fq, const LAS float* rstab) const {
        const int row0 = u.pm * BM + wr * 64 + fr, col0 = u.pn * HALF + wc * 32 + 8 * fq;
        float rs[2][4];
#pragma unroll
        for (int ai = 0; ai < 2; ++ai)
#pragma unroll
            for (int m = 0; m < 4; ++m) rs[ai][m] = rstab[ai * HALF + wr * 64 + m * 16 + fr];
        if (u.pn >= pn_plain) {
            const int c0 = (u.pn - pn_plain) * BM + wc * 32 + 8 * fq;
#pragma unroll
            for (int ai = 0; ai < 2; ++ai)
#pragma unroll
                for (int m = 0; m < 4; ++m) { float* rowp = OF2 + (size_t)(row0 + ai * HALF + m * 16) * DM + c0; const float r1 = rs[ai][m];
#pragma unroll
                    for (int bj = 0; bj < 2; ++bj)
#pragma unroll
                        for (int n = 0; n < 2; ++n) *(f32x4*)(rowp + bj * HALF + 4 * n) = acc[ai][bj][m][n] * r1; }
        } else if (mode == 0) {
#pragma unroll
            for (int ai = 0; ai < 2; ++ai)
#pragma unroll
                for (int m = 0; m < 4; ++m) { const size_t off = (size_t)(row0 + ai * HALF + m * 16) * ldo + col0; const float r1 = rs[ai][m], r2 = r1 * (-1.44269504f);
                    f32x4 r[2];
#pragma unroll
                    for (int n = 0; n < 2; ++n) { const f32x4 p = acc[ai][0][m][n], q = acc[ai][1][m][n];
#pragma unroll
                        for (int j = 0; j < 4; ++j) { const float e = __builtin_amdgcn_exp2f(p[j] * r2); r[n][j] = (p[j] * r1) * (q[j] * r1) * __builtin_amdgcn_rcpf(1.0f + e); } }
                    u32x4 w; w.x = cvt_pk_bf16(r[0][0], r[0][1]); w.y = cvt_pk_bf16(r[0][2], r[0][3]); w.z = cvt_pk_bf16(r[1][0], r[1][1]); w.w = cvt_pk_bf16(r[1][2], r[1][3]); *(u32x4*)(O + off) = w; }
        } else if (mode == 1) {
#pragma unroll
            for (int ai = 0; ai < 2; ++ai)
#pragma unroll
                for (int m = 0; m < 4; ++m) { const size_t off = (size_t)(row0 + ai * HALF + m * 16) * ldo + col0; const float r1 = rs[ai][m], r2 = r1 * (-1.44269504f);
#pragma unroll
                    for (int n = 0; n < 2; ++n) { const f32x4 p = acc[ai][0][m][n], q = acc[ai][1][m][n]; f32x4 r;
#pragma unroll
                        for (int j = 0; j < 4; ++j) { const float e = __builtin_amdgcn_exp2f(q[j] * r2); r[j] = (p[j] * r1) * __builtin_amdgcn_rcpf(1.0f + e); }
                        *(f32x4*)(OF + off + 4 * n) = r; } }
        } else {
#pragma unroll
            for (int ai = 0; ai < 2; ++ai)
#pragma unroll
                for (int m = 0; m < 4; ++m) { const size_t off = (size_t)(row0 + ai * HALF + m * 16) * ldo + col0; const float r1 = rs[ai][m] * rs[ai][m];
#pragma unroll
                    for (int n = 0; n < 2; ++n) *(f32x4*)(OF + off + 4 * n) = acc[ai][0][m][n] * acc[ai][1][m][n] * r1; }
        }
        if (pub && u.pm >= 64) {
            asm volatile("s_waitcnt vmcnt(0)" ::: "memory"); __builtin_amdgcn_s_barrier(); asm volatile("" ::: "memory");
            if (threadIdx.x == 0) { __builtin_amdgcn_fence(__ATOMIC_RELEASE, "agent"); asm volatile("s_waitcnt vmcnt(0)" ::: "memory"); __hip_atomic_fetch_add(pub, 1u, __ATOMIC_RELAXED, __HIP_MEMORY_SCOPE_AGENT); }
        }
    }
};
struct EpiSlab {
    static constexpr bool PERM = false;
    static constexpr bool USE_RS = false;
    float* F; float* FX; const float* SS;
    __device__ __forceinline__ void operator()(f32x4 (&acc)[2][2][4][2], const Unit& u, int wr, int wc, int fr, int fq, const LAS float*) const {
        const int row0 = u.pm * BM + wr * 64 + fr, col0 = u.pn * BM + wc * 32 + 4 * fq;
        float* base = (u.z == 0) ? F + (size_t)row0 * DM : FX + ((size_t)(u.z - 1) * TS + (row0 - TP)) * DM;
#pragma unroll
        for (int ai = 0; ai < 2; ++ai)
#pragma unroll
            for (int m = 0; m < 4; ++m) { float* rowp = base + (size_t)(ai * HALF + m * 16) * DM + col0;
#pragma unroll
                for (int bj = 0; bj < 2; ++bj)
#pragma unroll
                    for (int n = 0; n < 2; ++n) *(f32x4*)(rowp + bj * HALF + n * 16) = acc[ai][bj][m][n]; }
    }
};
struct EpiResNorm {
    static constexpr bool PERM = true;
    static constexpr bool USE_RS = false;
    float* h; const float* hsrc; bf16_t* hb; float* SS; float* F; float* FX; const float* gA; const float* gB; const float* cscale; float scale; int last;
    float* xbuf; unsigned* cnt; unsigned target; LAS float* tab;
    __device__ __forceinline__ void operator()(f32x4 (&acc)[2][2][4][2], const Unit& u, int wr_, int wc_, int fr_, int fq_, const LAS float*) const {
        int tid = threadIdx.x; asm volatile("" : "+v"(tid));
        const int lane = tid & 63, wid = __builtin_amdgcn_readfirstlane(tid >> 6), wr = wid >> 2, wc = wid & 3, fr = lane & 15, fq = lane >> 4;
        (void)wr_; (void)wc_; (void)fr_; (void)fq_;
        const int col0 = u.pn * BM + wc * 32 + 8 * fq;
        if (cscale) {
#pragma unroll
            for (int bj = 0; bj < 2; ++bj)
#pragma unroll
                for (int n = 0; n < 2; ++n) { const f32x4 sv = *(const f32x4*)(cscale + col0 + bj * HALF + n * 4);
#pragma unroll
                    for (int ai = 0; ai < 2; ++ai)
#pragma unroll
                        for (int m = 0; m < 4; ++m) acc[ai][bj][m][n] *= sv; }
        }
        if (u.pm >= 64) {
            const int row0 = u.pm * BM + wr * 64 + fr;
            float* base = (u.z == 0) ? F + (size_t)row0 * DM : FX + ((size_t)(u.z - 1) * TS + (row0 - TP)) * DM;
#pragma unroll
            for (int ai = 0; ai < 2; ++ai)
#pragma unroll
                for (int m = 0; m < 4; ++m) { float* rowp = base + (size_t)(ai * HALF + m * 16) * DM + col0;
#pragma unroll
                    for (int bj = 0; bj < 2; ++bj)
#pragma unroll
                        for (int n = 0; n < 2; ++n) *(f32x4*)(rowp + bj * HALF + n * 4) = acc[ai][bj][m][n]; }
            return;
        }
        LAS float* P = tab; LAS float* S = tab + 1024;
        f32x4 hbuf[2][4], gav[4], gbv[4];
        { const size_t off0 = (size_t)(u.pm * BM + wr * 64 + fr) * DM + col0;
#pragma unroll
            for (int q = 0; q < 4; ++q) { const int cc = (q >> 1) * HALF + (q & 1) * 4; hbuf[0][q] = *(const f32x4*)(hsrc + off0 + cc); gav[q] = *(const f32x4*)(gA + col0 + cc); gbv[q] = last ? (f32x4){0.f, 0.f, 0.f, 0.f} : *(const f32x4*)(gB + col0 + cc); } }
        f32x4 warm = (f32x4){0.f, 0.f, 0.f, 0.f};
#pragma unroll 1
        for (int g = 1; g < 8; ++g) { const float* hp = hsrc + (size_t)(u.pm * BM + (g >> 2) * HALF + wr * 64 + (g & 3) * 16 + fr) * DM + col0;
            asm volatile("global_load_dwordx4 %0, %1, off\n\tglobal_load_dwordx4 %0, %1, off offset:16\n\tglobal_load_dwordx4 %0, %1, off offset:512\n\tglobal_load_dwordx4 %0, %1, off offset:528" : "+v"(warm) : "v"(hp) : "memory"); }
#pragma unroll
        for (int ai = 0; ai < 2; ++ai)
#pragma unroll
            for (int m = 0; m < 4; ++m) { float s = 0.f;
#pragma unroll
                for (int bj = 0; bj < 2; ++bj)
#pragma unroll
                    for (int n = 0; n < 2; ++n) { const f32x4 x = acc[ai][bj][m][n]; s += (x[0] * x[0] + x[1] * x[1]) + (x[2] * x[2] + x[3] * x[3]); }
                s += __shfl_xor(s, 16); s += __shfl_xor(s, 32);
                if (fq == 0) P[(ai * HALF + wr * 64 + m * 16 + fr) * 4 + wc] = s; }
        asm volatile("s_waitcnt lgkmcnt(0)" ::: "memory"); __builtin_amdgcn_s_barrier(); asm volatile("" ::: "memory");
        const int row = wid * 32 + (lane & 31);
        if (lane < 32) { const f32x4 pp = *(const LAS f32x4*)(P + row * 4);
            __hip_atomic_store(xbuf + ((size_t)(u.pm * BM + row) * 4 + u.pn), (pp.x + pp.y) + (pp.z + pp.w), __ATOMIC_RELAXED, __HIP_MEMORY_SCOPE_AGENT); }
        asm volatile("s_waitcnt vmcnt(0)" : "+v"(warm) :: "memory");
        if (lane == 0) __hip_atomic_fetch_add(cnt + 64 * u.pm, 1u, __ATOMIC_RELAXED, __HIP_MEMORY_SCOPE_AGENT);
        if (wid == 0) {
            unsigned sp = 0;
            while ((unsigned)__builtin_amdgcn_readfirstlane(__hip_atomic_load(cnt + 64 * u.pm, __ATOMIC_RELAXED, __HIP_MEMORY_SCOPE_AGENT)) < target) { __builtin_amdgcn_s_sleep(1); if (++sp > (1u << 22)) break; }
            __builtin_amdgcn_fence(__ATOMIC_ACQUIRE, "agent");
        }
        asm volatile("s_waitcnt vmcnt(0) lgkmcnt(0)" ::: "memory"); __builtin_amdgcn_s_barrier(); asm volatile("" ::: "memory");
        if (lane < 32) { const float* slot = xbuf + (size_t)(u.pm * BM + row) * 4; float tot = 0.f;
#pragma unroll
            for (int t = 0; t < 4; ++t) tot += __hip_atomic_load(slot + t, __ATOMIC_RELAXED, __HIP_MEMORY_SCOPE_AGENT);
            S[row] = scale * __builtin_amdgcn_rsqf(tot * (1.0f / DM) + EPS); }
        asm volatile("s_waitcnt vmcnt(0) lgkmcnt(0)" ::: "memory"); __builtin_amdgcn_s_barrier(); asm volatile("" ::: "memory");
#pragma unroll
        for (int g = 0; g < 8; ++g) { const int ai = g >> 2, m = g & 3;
            if (g + 1 < 8) { const int ai2 = (g + 1) >> 2, m2 = (g + 1) & 3; const size_t off2 = (size_t)(u.pm * BM + ai2 * HALF + wr * 64 + m2 * 16 + fr) * DM + col0;
#pragma unroll
                for (int q = 0; q < 4; ++q) hbuf[(g + 1) & 1][q] = *(const f32x4*)(hsrc + off2 + (q >> 1) * HALF + (q & 1) * 4); }
            asm volatile("" ::: "memory");
            const int r = ai * HALF + wr * 64 + m * 16 + fr; const float rs = S[r]; const size_t off = (size_t)(u.pm * BM + r) * DM + col0; float s2 = 0.f;
#pragma unroll
            for (int bj = 0; bj < 2; ++bj) { u32x4 w4;
#pragma unroll
                for (int n = 0; n < 2; ++n) { const int q = 2 * bj + n, cc = bj * HALF + n * 4;
                    const f32x4 hv = hbuf[g & 1][q] + acc[ai][bj][m][n] * rs * gav[q]; *(f32x4*)(h + off + cc) = hv;
                    s2 += (hv[0] * hv[0] + hv[1] * hv[1]) + (hv[2] * hv[2] + hv[3] * hv[3]);
                    const f32x4 x = hv * gbv[q]; if (n == 0) { w4.x = cvt_pk_bf16(x[0], x[1]); w4.y = cvt_pk_bf16(x[2], x[3]); } else { w4.z = cvt_pk_bf16(x[0], x[1]); w4.w = cvt_pk_bf16(x[2], x[3]); } }
                if (!last) *(u32x4*)(hb + off + bj * HALF) = w4; }
            s2 += __shfl_xor(s2, 16); s2 += __shfl_xor(s2, 32);
            if (fq == 0) P[r * 4 + wc] = s2;
            asm volatile("" ::: "memory"); }
        asm volatile("s_waitcnt lgkmcnt(0)" ::: "memory"); __builtin_amdgcn_s_barrier(); asm volatile("" ::: "memory");
        if (lane < 32) { const f32x4 pp = *(const LAS f32x4*)(P + row * 4); SS[(size_t)(u.pm * BM + row) * 4 + u.pn] = (pp.x + pp.y) + (pp.z + pp.w); }
        asm volatile("s_waitcnt lgkmcnt(0)" ::: "memory"); __builtin_amdgcn_s_barrier(); asm volatile("" ::: "memory");
    }
};

template <class Epi>
__device__ __forceinline__ void gemm_phase(LAS unsigned char* lds, const Sched& S, const Epi& E, unsigned long long* probe = nullptr) {
    int tid = threadIdx.x; asm volatile("" : "+v"(tid));
    const int wid = __builtin_amdgcn_readfirstlane(tid >> 6), lane = tid & 63, wr = wid >> 2, wc = wid & 3, fr = lane & 15, fq = lane >> 4;
    const int lda = S.lda, ldb = S.ldb;
    unsigned voffA[2], voffB[2];
#pragma unroll
    for (int i = 0; i < 2; ++i) { int R, C; stage_rc(tid * 16 + i * 8192, R, C); const int Rb = Epi::PERM ? ((R & ~31) + perm32(R & 31)) : R;
        voffA[i] = (unsigned)(R * lda + C) * 2u; voffB[i] = (unsigned)(Rb * ldb + C) * 2u; }
    const size_t kstep = (size_t)(BK * 2);
    const size_t hstepA = (size_t)HALF * lda * 2, hstepB = (size_t)HALF * ldb * 2;
    const unsigned ldsw = (unsigned)wid * 1024u;
    const int aoff = lds_byte(wr * 64 + fr, fq * 8), boff = lds_byte(wc * 32 + fr, fq * 8);
#define PG8_SA(b, h) (((b) * 2 + (h)) * HTB)
#define PG8_SB(b, h) ((4 + (b) * 2 + (h)) * HTB)
#define PG8_STAGE(bufoff, gbase, voff) do { _Pragma("unroll") for (int _i = 0; _i < 2; ++_i) \
        __builtin_amdgcn_global_load_lds((const unsigned*)((const char*)(gbase) + (voff)[_i]), (LAS unsigned*)(lds + (bufoff) + ldsw + _i * 8192), 16, 0, 0); } while (0)
#define PG8_LDA(dst, b, h) do { _Pragma("unroll") for (int m = 0; m < 4; ++m) _Pragma("unroll") for (int k = 0; k < 2; ++k) dst[m][k] = *(const LAS bf16x8*)(lds + PG8_SA(b, h) + aoff + m * 2048 + k * 1024); } while (0)
#define PG8_LDB(dst, b, h) do { _Pragma("unroll") for (int n = 0; n < 2; ++n) _Pragma("unroll") for (int k = 0; k < 2; ++k) dst[n][k] = *(const LAS bf16x8*)(lds + PG8_SB(b, h) + boff + n * 2048 + k * 1024); } while (0)
#define PG8_MMA(ai, bj, At, Bt) do { __builtin_amdgcn_s_setprio(1); _Pragma("unroll") for (int m = 0; m < 4; ++m) _Pragma("unroll") for (int n = 0; n < 2; ++n) _Pragma("unroll") for (int k = 0; k < 2; ++k) \
        acc[ai][bj][m][n] = __builtin_amdgcn_mfma_f32_16x16x32_bf16(Bt[n][k], At[m][k], acc[ai][bj][m][n], 0, 0, 0); __builtin_amdgcn_s_setprio(0); } while (0)
#define PG8_WAIT_V(n) asm volatile("s_waitcnt vmcnt(" #n ")" ::: "memory")
#define PG8_WAIT_L(n) asm volatile("s_waitcnt lgkmcnt(" #n ")" ::: "memory")
#define PG8_BAR __builtin_amdgcn_s_barrier()
#define PG8_SCHED __builtin_amdgcn_sched_barrier(0)
    Unit cur, nxt; int ui = 0;
    if (!S.next(0, cur)) return;
    f32x4 acc[2][2][4][2];
#pragma unroll
    for (int a = 0; a < 2; ++a)
#pragma unroll
        for (int b = 0; b < 2; ++b)
#pragma unroll
            for (int m = 0; m < 4; ++m)
#pragma unroll
                for (int n = 0; n < 2; ++n) acc[a][b][m][n] = (f32x4){0.f, 0.f, 0.f, 0.f};
    bf16x8 At[4][2], B0[2][2], B1[2][2];
    const char* cA = cur.a; const char* cB = cur.b;
    LAS float* rstab = (LAS float*)(lds + LDS_TAB);
    if constexpr (Epi::USE_RS) { if (tid < 256) rstab[tid] = row_rs(E.SS, cur.pm * BM + tid); }
    PG8_STAGE(PG8_SB(0, 0), cB, voffB); PG8_STAGE(PG8_SB(0, 1), cB + hstepB, voffB); PG8_STAGE(PG8_SA(0, 0), cA, voffA); PG8_STAGE(PG8_SA(0, 1), cA + hstepA, voffA);
    if (wr == 1) PG8_BAR;
    PG8_WAIT_V(2); PG8_BAR;
    PG8_STAGE(PG8_SB(1, 0), cB + kstep, voffB); PG8_STAGE(PG8_SA(1, 0), cA + kstep, voffA); PG8_STAGE(PG8_SB(1, 1), cB + hstepB + kstep, voffB);
    PG8_WAIT_V(6); PG8_BAR;
    for (;;) {
        const bool has_next = S.next(ui + 1, nxt);
        const char* nA = has_next ? nxt.a : cA; const char* nB = has_next ? nxt.b : cB;
        const int nt = cur.nt;
        for (int t = 0; t < nt; t += 2) {
            const bool last = (t == nt - 2);
            const char* a1 = cA + (size_t)(t + 1) * kstep;
            const char* a2 = last ? nA : cA + (size_t)(t + 2) * kstep; const char* b2 = last ? nB : cB + (size_t)(t + 2) * kstep;
            const char* a3 = a2 + kstep; const char* b3 = b2 + kstep;
            PG8_LDB(B0, 0, 0); PG8_LDB(B1, 0, 1); PG8_SCHED; PG8_LDA(At, 0, 0); PG8_STAGE(PG8_SA(1, 1), a1 + hstepA, voffA);
            PG8_WAIT_V(8); PG8_WAIT_L(0); PG8_BAR; PG8_MMA(0, 0, At, B0); PG8_MMA(0, 1, At, B1); PG8_BAR; PG8_SCHED;
            PG8_LDA(At, 0, 1); PG8_STAGE(PG8_SB(0, 0), b2, voffB); PG8_STAGE(PG8_SB(0, 1), b2 + hstepB, voffB); PG8_STAGE(PG8_SA(0, 0), a2, voffA);
            PG8_WAIT_V(8); PG8_WAIT_L(0); PG8_BAR; PG8_MMA(1, 0, At, B0); PG8_MMA(1, 1, At, B1); PG8_BAR; PG8_SCHED;
            PG8_LDB(B0, 1, 0); PG8_LDB(B1, 1, 1); PG8_SCHED; PG8_LDA(At, 1, 0); PG8_STAGE(PG8_SA(0, 1), a2 + hstepA, voffA);
            PG8_WAIT_V(8); PG8_WAIT_L(0); PG8_BAR; PG8_MMA(0, 0, At, B0); PG8_MMA(0, 1, At, B1); PG8_BAR; PG8_SCHED;
            PG8_LDA(At, 1, 1); PG8_STAGE(PG8_SB(1, 0), b3, voffB); PG8_STAGE(PG8_SB(1, 1), b3 + hstepB, voffB); PG8_STAGE(PG8_SA(1, 0), a3, voffA);
            PG8_WAIT_V(8); PG8_WAIT_L(0); PG8_BAR; PG8_MMA(1, 0, At, B0); PG8_MMA(1, 1, At, B1); PG8_BAR; PG8_SCHED;
        }
        if (wr == 0) PG8_BAR;
#ifdef PROBE_CLASS
        unsigned long long pe0 = 0; if (probe) { asm volatile("s_waitcnt vmcnt(0)" ::: "memory"); pe0 = __builtin_amdgcn_s_memrealtime(); }
#endif
        f32x4 ssn = (f32x4){0.f, 0.f, 0.f, 0.f};
        if constexpr (Epi::USE_RS) { if (has_next && tid < 256) ssn = *(const f32x4*)(E.SS + (size_t)(nxt.pm * BM + tid) * 4); }
        E(acc, cur, wr, wc, fr, fq, rstab + (ui & 1) * 256);
        if constexpr (Epi::USE_RS) { if (has_next && tid < 256) rstab[((ui + 1) & 1) * 256 + tid] = __builtin_amdgcn_rsqf(((ssn.x + ssn.y) + (ssn.z + ssn.w)) * (1.0f / DM) + EPS); }
#ifdef PROBE_CLASS
        if (probe) { asm volatile("s_waitcnt vmcnt(0)" ::: "memory"); if (blockIdx.x == 0 && threadIdx.x == 0) *probe += __builtin_amdgcn_s_memrealtime() - pe0; }
#endif
        if (!has_next) break;
#pragma unroll
        for (int a = 0; a < 2; ++a)
#pragma unroll
            for (int b = 0; b < 2; ++b)
#pragma unroll
                for (int m = 0; m < 4; ++m)
#pragma unroll
                    for (int n = 0; n < 2; ++n) acc[a][b][m][n] = (f32x4){0.f, 0.f, 0.f, 0.f};
        cur = nxt; cA = nA; cB = nB; ++ui;
        if (wr == 1) PG8_BAR;
    }
    PG8_WAIT_V(0);
    PG8_BAR;
#undef PG8_SA
#undef PG8_SB
#undef PG8_STAGE
#undef PG8_LDA
#undef PG8_LDB
#undef PG8_MMA
#undef PG8_WAIT_V
#undef PG8_WAIT_L
#undef PG8_BAR
#undef PG8_SCHED
}
}

#define LDS_WAIT() asm volatile("s_waitcnt lgkmcnt(0)" ::: "memory")
__device__ __forceinline__ void transpose_item(const float* W, int N, bf16_t* WT, int K, int k0, int n0, int r0, LAS float* scr, int lane) {
    float wv[32];
#pragma unroll
    for (int i = 0; i < 32; ++i) wv[i] = W[(size_t)(k0 + 2 * i + (lane >> 5)) * N + n0 + (lane & 31)];
#pragma unroll
    for (int i = 0; i < 32; ++i) scr[(2 * i + (lane >> 5)) * 33 + (lane & 31)] = wv[i];
    LDS_WAIT();
    const int c = lane & 7;
#pragma unroll
    for (int j = 0; j < 4; ++j) { const int n = (lane >> 3) + 8 * j; const LAS float* s = scr + (8 * c) * 33 + n;
        u32x4 o; o.x = cvt_pk_bf16(s[0 * 33], s[1 * 33]); o.y = cvt_pk_bf16(s[2 * 33], s[3 * 33]); o.z = cvt_pk_bf16(s[4 * 33], s[5 * 33]); o.w = cvt_pk_bf16(s[6 * 33], s[7 * 33]);
        *(u32x4*)(WT + (size_t)(r0 + n) * K + k0 + 8 * c) = o; }
    LDS_WAIT();
}
__device__ __forceinline__ void convert_matrix(const float* W, int K, int N, int half, bf16_t* WT, int item, LAS float* scr, int lane) {
    const int nblk = N / 32, kb = item / nblk, nb = item % nblk, r0 = nb * 32;
    const int n0 = half ? (((r0 >> 7) & 1) * half + (r0 >> 8) * 128 + (r0 & 127)) : r0;
    transpose_item(W, N, WT, K, kb * 64, n0, r0, scr, lane);
}

__device__ __forceinline__ void phase_prologue(KP p, LAS unsigned char* lds, int gw, int ngw, int wave, int lane) {
    LAS float* scr = (LAS float*)(lds + wave * 16384);
    unsigned char* ws = p->ws;
    constexpr int I_FIN = 16 * 176, I_FDN = 44 * 32, I_AIN = 16 * 64, I_SQ = 16 * 32, I_BIN = 16 * 96, I_D = 4 * 8;
    constexpr int NITEMS = 8 * I_FIN + 8 * I_FDN + I_AIN + I_SQ + I_BIN + I_SQ + I_AIN + I_SQ + 4 * I_D;
    for (int it = gw; it < NITEMS; it += ngw) {
        int r = it;
        if (r < 8 * I_FIN) { const int m = r / I_FIN; if (m >= 1) continue;
            convert_matrix(p->in[6] + (size_t)m * DM * 2 * DFF, DM, 2 * DFF, DFF, (bf16_t*)(ws + WS_W_FFN_IN + m * SZ_FFN_IN), r % I_FIN, scr, lane); continue; } r -= 8 * I_FIN;
        if (r < 8 * I_FDN) { const int m = r / I_FDN; if (m == 1 || (m >= 2 && (r % I_FDN) < 1280)) continue;
            convert_matrix(p->in[7] + (size_t)m * DFF * DM, DFF, DM, 0, (bf16_t*)(ws + WS_W_FFN_DN + m * SZ_FFN_DN), r % I_FDN, scr, lane); continue; } r -= 8 * I_FDN;
        if (r < I_AIN + I_SQ) continue;
        r -= I_AIN + I_SQ;
        if (r < I_BIN + I_SQ + I_AIN + I_SQ + 4 * I_D) continue;
        if (r < I_BIN) {
            const int nblk = 96, kb = r / nblk, nb = r % nblk, r0 = nb * 32;
            const int n0 = (r0 < 2048) ? (1024 + ((r0 >> 7) & 1) * 1024 + (r0 >> 8) * 128 + (r0 & 127)) : (r0 - 2048);
            transpose_item(p->in[14], 3072, (bf16_t*)(ws + WS_W_B_IN), DM, kb * 64, n0, r0, scr, lane); continue; } r -= I_BIN;
        if (r < I_SQ) { convert_matrix(p->in[16], DM, DM, 0, (bf16_t*)(ws + WS_W_B_OUT), r, scr, lane); continue; } r -= I_SQ;
        if (r < I_AIN) { convert_matrix(p->in[17], DM, 2048, 0, (bf16_t*)(ws + WS_W_C_IN), r, scr, lane); continue; } r -= I_AIN;
        if (r < I_SQ) { convert_matrix(p->in[22], DM, DM, 0, (bf16_t*)(ws + WS_W_C_OUT), r, scr, lane); continue; } r -= I_SQ;
        { const int g = r / I_D; convert_matrix(p->in[23] + (size_t)g * 65536, 256, 256, 0, (bf16_t*)(ws + WS_W_D) + (size_t)g * 65536, r % I_D, scr, lane); }
    }
    bf16_t* hb = (bf16_t*)(ws + WS_HB); const float* g0 = p->in[5];
    for (int t = gw; t < NTOK; t += ngw) {
        const float* src = (t < TP) ? p->in[0] + (size_t)t * DM : p->in[1] + (size_t)(t - TP) * DM;
        const f32x4* xr = (const f32x4*)src + lane; f32x4 v[4]; float ss = 0.f;
#pragma unroll
        for (int j = 0; j < 4; ++j) { v[j] = xr[64 * j]; ss += (v[j].x * v[j].x + v[j].y * v[j].y) + (v[j].z * v[j].z + v[j].w * v[j].w); }
        ss = wave_sum(ss);
        if (lane == 0) *(f32x4*)((float*)(ws + WS_SS) + (size_t)t * 4) = (f32x4){ss, 0.f, 0.f, 0.f};
        u32x2* ob = (u32x2*)(hb + (size_t)t * DM) + lane;
#pragma unroll
        for (int j = 0; j < 4; ++j) { const f32x4 g = ((const f32x4*)g0)[lane + 64 * j]; const f32x4 x = v[j] * g;
            u32x2 w; w.x = cvt_pk_bf16(x.x, x.y); w.y = cvt_pk_bf16(x.z, x.w); ob[64 * j] = w; }
    }
}

__device__ __forceinline__ void convert_mixer_weights(KP p, int nl, LAS unsigned char* lds, int gwx, int ngwx, int wave, int lane) {
    LAS float* scr = (LAS float*)(lds + wave * 16384); unsigned char* ws = p->ws;
    constexpr int I_AIN = 16 * 64, I_SQ = 16 * 32, I_BIN = 16 * 96, I_D = 4 * 8;
    const int n = (nl == 1) ? I_BIN + I_SQ : (nl == 2 ? I_AIN + I_SQ : 4 * I_D);
    for (int it = gwx; it < n; it += ngwx) { int r = it;
        if (nl == 1) {
            if (r < I_BIN) { const int nblk = 96, kb = r / nblk, nb = r % nblk, r0 = nb * 32;
                const int n0 = (r0 < 2048) ? (1024 + ((r0 >> 7) & 1) * 1024 + (r0 >> 8) * 128 + (r0 & 127)) : (r0 - 2048);
                transpose_item(p->in[14], 3072, (bf16_t*)(ws + WS_W_B_IN), DM, kb * 64, n0, r0, scr, lane); }
            else convert_matrix(p->in[16], DM, DM, 0, (bf16_t*)(ws + WS_W_B_OUT), r - I_BIN, scr, lane);
        } else if (nl == 2) {
            if (r < I_AIN) convert_matrix(p->in[17], DM, 2048, 0, (bf16_t*)(ws + WS_W_C_IN), r, scr, lane);
            else convert_matrix(p->in[22], DM, DM, 0, (bf16_t*)(ws + WS_W_C_OUT), r - I_AIN, scr, lane);
        } else { const int g = r / I_D; convert_matrix(p->in[23] + (size_t)g * 65536, 256, 256, 0, (bf16_t*)(ws + WS_W_D) + (size_t)g * 65536, r % I_D, scr, lane); }
    }
}
__device__ __forceinline__ void convert_ffn_in_layer(KP p, int nl, LAS unsigned char* lds, int gwx, int ngwx, int wave, int lane) {
    LAS float* scr = (LAS float*)(lds + wave * 16384);
    constexpr int I_FIN = 16 * 176;
    for (int it = gwx; it < 2 * I_FIN; it += ngwx) { const int m = 2 * nl + it / I_FIN;
        convert_matrix(p->in[6] + (size_t)m * DM * 2 * DFF, DM, 2 * DFF, DFF, (bf16_t*)(p->ws + WS_W_FFN_IN + m * SZ_FFN_IN), it % I_FIN, scr, lane); }
}

__device__ __forceinline__ void phase_resnorm_sample(float* h, const float* hsrc, const float* F, const float* FX, int ns, float scale, const float* gA, const float* gB,
                                                     bf16_t* hb, float* SS, int last, int gw, int ngw, int lane) {
    for (int t = TP + gw; t < NTOK; t += ngw) {
        const f32x4* fr = (const f32x4*)(F + (size_t)t * DM) + lane; f32x4 f[4];
#pragma unroll
        for (int j = 0; j < 4; ++j) f[j] = fr[64 * j];
#pragma unroll
        for (int zb = 0; zb < 2; ++zb) { f32x4 tmp[5][4];
#pragma unroll
            for (int k = 0; k < 5; ++k) { const int z = 1 + zb * 5 + k; const f32x4* xr = (const f32x4*)(FX + ((size_t)((z < ns ? z : 1) - 1) * TS + (t - TP)) * DM) + lane;
#pragma unroll
                for (int j = 0; j < 4; ++j) tmp[k][j] = xr[64 * j]; }
#pragma unroll
            for (int k = 0; k < 5; ++k) { const float fac = (1 + zb * 5 + k < ns) ? 1.0f : 0.0f;
#pragma unroll
                for (int j = 0; j < 4; ++j) f[j] += tmp[k][j] * fac; } }
        float ss = 0.f;
#pragma unroll
        for (int j = 0; j < 4; ++j) ss += (f[j].x * f[j].x + f[j].y * f[j].y) + (f[j].z * f[j].z + f[j].w * f[j].w);
        const float rs = scale / sqrtf(wave_sum(ss) * (1.0f / DM) + EPS);
        f32x4* hr = (f32x4*)(h + (size_t)t * DM) + lane; const f32x4* hs = (const f32x4*)(hsrc + (size_t)t * DM) + lane; f32x4 hv[4]; float s2 = 0.f;
#pragma unroll
        for (int j = 0; j < 4; ++j) { const f32x4 g = ((const f32x4*)gA)[lane + 64 * j]; hv[j] = hs[64 * j] + f[j] * rs * g; hr[64 * j] = hv[j];
            s2 += (hv[j].x * hv[j].x + hv[j].y * hv[j].y) + (hv[j].z * hv[j].z + hv[j].w * hv[j].w); }
        if (!last) {
            s2 = wave_sum(s2);
            if (lane == 0) *(f32x4*)(SS + (size_t)t * 4) = (f32x4){s2, 0.f, 0.f, 0.f};
            u32x2* ob = (u32x2*)(hb + (size_t)t * DM) + lane;
#pragma unroll
            for (int j = 0; j < 4; ++j) { const f32x4 g = ((const f32x4*)gB)[lane + 64 * j]; const f32x4 x = hv[j] * g;
                u32x2 w; w.x = cvt_pk_bf16(x.x, x.y); w.y = cvt_pk_bf16(x.z, x.w); ob[64 * j] = w; }
        }
    }
}

__device__ __forceinline__ void phase_conv(KP p, const float* glu, bf16_t* yb, LAS unsigned char* lds, int c, int G, int wave, int lane) {
    const float* state_a = p->in[2]; const float* cw = p->in[9]; const float* cbias = p->in[10]; const float* lg = p->in[11]; const float* lb = p->in[12];
    LAS float* buf = (LAS float*)lds;
    const int ch = wave * 128 + lane * 2;
    f32x2 w[31];
#pragma unroll
    for (int j = 0; j < 31; ++j) w[j] = *(const f32x2*)(cw + j * DM + ch);
    const f32x2 bias = *(const f32x2*)(cbias + ch);
    for (int gp = c; gp < NTOK / 8; gp += G) {
#pragma unroll 1
        for (int gsel = 0; gsel < 2; ++gsel) {
            const int t0 = 8 * gp + 4 * gsel; const bool samp = t0 >= TP;
            const int b = samp ? ((t0 - TP) >> 2) : (t0 >> 11), s0 = samp ? 0 : (t0 & 2047);
            f32x2 acc[4] = {bias, bias, bias, bias};
#pragma unroll
            for (int r = 0; r < 34; ++r) {
                const int rel = r - 30;
                const float* ptr; float fac = 1.0f;
                if (rel >= 0) ptr = glu + (size_t)(t0 + rel) * DM;
                else if (samp) ptr = state_a + ((size_t)b * 30 + 30 + rel) * DM;
                else { const bool ok = (s0 + rel >= 0); ptr = glu + (size_t)(ok ? t0 + rel : t0) * DM; fac = ok ? 1.0f : 0.0f; }
                f32x2 x = *(const f32x2*)(ptr + ch); if (rel < 0) x = x * fac;
#pragma unroll
                for (int o = 0; o < 4; ++o) { const int j = r - o; if (j >= 0 && j <= 30) acc[o] += w[j] * x; }
            }
#pragma unroll
            for (int o = 0; o < 4; ++o) *(LAS f32x2*)(buf + (gsel * 4 + o) * DM + ch) = acc[o];
        }
        __syncthreads();
        {
            const int t = 8 * gp + wave; const LAS f32x4* br = (const LAS f32x4*)(buf + wave * DM) + lane; f32x4 v[4]; float s = 0.f;
#pragma unroll
            for (int j = 0; j < 4; ++j) { v[j] = br[64 * j]; s += (v[j].x + v[j].y) + (v[j].z + v[j].w); }
            const float mean = wave_sum(s) * (1.0f / DM); float s2 = 0.f;
#pragma unroll
            for (int j = 0; j < 4; ++j) { v[j] = v[j] - mean; s2 += (v[j].x * v[j].x + v[j].y * v[j].y) + (v[j].z * v[j].z + v[j].w * v[j].w); }
            const float rstd = 1.0f / sqrtf(wave_sum(s2) * (1.0f / DM) + EPS);
            u32x2* ob = (u32x2*)(yb + (size_t)t * DM) + lane;
#pragma unroll
            for (int j = 0; j < 4; ++j) { const f32x4 g = ((const f32x4*)lg)[lane + 64 * j], bb = ((const f32x4*)lb)[lane + 64 * j]; f32x4 y = v[j] * rstd * g + bb;
#pragma unroll
                for (int e = 0; e < 4; ++e) y[e] = y[e] * sigmoid_f(y[e]);
                u32x2 o; o.x = cvt_pk_bf16(y.x, y.y); o.y = cvt_pk_bf16(y.z, y.w); ob[64 * j] = o; }
        }
        __syncthreads();
    }
    const int gw = c * NWAVES + wave, ngw = G * NWAVES;
    for (int it = gw; it < (8 + 128) * 30; it += ngw) {
        const float* src; float* dst;
        if (it < 240) { const int b = it / 30, r = it % 30; src = glu + ((size_t)b * 2048 + 2018 + r) * DM; dst = p->out + O_SA_P + (size_t)it * DM; }
        else { const int e = it - 240, b = e / 30, r = e % 30; src = (r < 26) ? state_a + ((size_t)b * 30 + r + 4) * DM : glu + ((size_t)TP + b * 4 + r - 26) * DM; dst = p->out + O_SA_S + (size_t)e * DM; }
#pragma unroll
        for (int j = 0; j < 4; ++j) ((f32x4*)dst + lane)[64 * j] = ((const f32x4*)src + lane)[64 * j];
    }
}

__device__ __forceinline__ void phase_gate(KP p, const float* z, const float* bg, bf16_t* yb, int gw, int ngw, int lane) {
    const float* state_b = p->in[3]; const float* cw = p->in[15];
    for (int t = gw; t < NTOK; t += ngw) {
        const bool samp = t >= TP; const int b = samp ? ((t - TP) >> 2) : (t >> 11), s = samp ? ((t - TP) & 3) : (t & 2047);
        const float* r2 = z + (size_t)t * DM;
        const float* r1; const float* r0; float f1 = 1.f, f0 = 1.f;
        if (s >= 1) r1 = z + (size_t)(t - 1) * DM; else if (samp) r1 = state_b + ((size_t)b * 2 + 1) * DM; else { r1 = r2; f1 = 0.f; }
        if (s >= 2) r0 = z + (size_t)(t - 2) * DM; else if (samp) r0 = state_b + ((size_t)b * 2 + s) * DM; else { r0 = r2; f0 = 0.f; }
        u32x2* ob = (u32x2*)(yb + (size_t)t * DM) + lane;
        float* st = nullptr;
        if (!samp && s >= 2046) st = p->out + O_SB_P + ((size_t)b * 2 + (s - 2046)) * DM;
        if (samp && s >= 2) st = p->out + O_SB_S + ((size_t)b * 2 + (s - 2)) * DM;
#pragma unroll
        for (int j = 0; j < 4; ++j) {
            const f32x4 z2 = ((const f32x4*)r2 + lane)[64 * j], z1 = ((const f32x4*)r1 + lane)[64 * j] * f1, z0 = ((const f32x4*)r0 + lane)[64 * j] * f0;
            const f32x4 w0 = ((const f32x4*)cw + lane)[64 * j], w1 = ((const f32x4*)(cw + DM) + lane)[64 * j], w2 = ((const f32x4*)(cw + 2 * DM) + lane)[64 * j];
            const f32x4 g = ((const f32x4*)(bg + (size_t)t * DM) + lane)[64 * j];
            const f32x4 y = g * (w0 * z0 + w1 * z1 + w2 * z2);
            u32x2 o; o.x = cvt_pk_bf16(y.x, y.y); o.y = cvt_pk_bf16(y.z, y.w); ob[64 * j] = o;
            if (st) ((f32x4*)st + lane)[64 * j] = z2;
        }
    }
}

__device__ __forceinline__ void phase_vln(KP p, const float* zz, bf16_t* vn, int gw, int ngw, int lane) {
    const float* lg = p->in[18]; const float* lb = p->in[19];
    for (int t = gw; t < NTOK; t += ngw) {
        const f32x4* vr = (const f32x4*)(zz + (size_t)t * 2048 + 1024) + lane; f32x4 v[4]; float s = 0.f;
#pragma unroll
        for (int j = 0; j < 4; ++j) { v[j] = vr[64 * j]; s += (v[j].x + v[j].y) + (v[j].z + v[j].w); }
        const float mean = wave_sum(s) * (1.0f / DM); float s2 = 0.f;
#pragma unroll
        for (int j = 0; j < 4; ++j) { v[j] = v[j] - mean; s2 += (v[j].x * v[j].x + v[j].y * v[j].y) + (v[j].z * v[j].z + v[j].w * v[j].w); }
        const float rstd = 1.0f / sqrtf(wave_sum(s2) * (1.0f / DM) + EPS);
        u32x2* ob = (u32x2*)(vn + (size_t)t * DM) + lane;
#pragma unroll
        for (int j = 0; j < 4; ++j) { const f32x4 g = ((const f32x4*)lg)[lane + 64 * j], bb = ((const f32x4*)lb)[lane + 64 * j]; const f32x4 y = v[j] * rstd * g + bb;
            u32x2 o; o.x = cvt_pk_bf16(y.x, y.y); o.y = cvt_pk_bf16(y.z, y.w); ob[64 * j] = o;
            if (t >= TP) ((f32x4*)(p->out + O_SC_S + (size_t)(t - TP) * DM) + lane)[64 * j] = y; }
    }
}

__device__ __forceinline__ void phase_spatial(KP p, const float* zz, const float* vst, bf16_t* yb, LAS unsigned char* lds, int c, int G, int tid, int wave, int lane) {
    const float* wsp = p->in[20]; const float* bsp = p->in[21];
    constexpr int LD = 136;
    LAS bf16_t* WmL = (LAS bf16_t*)lds; LAS bf16_t* VT = (LAS bf16_t*)(lds + 128 * LD * 2); LAS f32x2* MR = (LAS f32x2*)(lds + 2 * 128 * LD * 2);
    const int hh = c & 7;
    const int cp = tid & 15;
    const f32x4 ga0 = *(const f32x4*)(p->in[18] + hh * 128 + cp * 8), ga1 = *(const f32x4*)(p->in[18] + hh * 128 + cp * 8 + 4);
    const f32x4 ba0 = *(const f32x4*)(p->in[19] + hh * 128 + cp * 8), ba1 = *(const f32x4*)(p->in[19] + hh * 128 + cp * 8 + 4);
    int wm_variant = -1;
    for (int u = c; u < 132 * 8; u += G) {
        const int h = u & 7, cu = u >> 3; const bool samp = cu >= 128; const int tok0 = samp ? TP + (cu - 128) * 128 : cu * 128;
        if (tid < 128) { const f32x4* q = (const f32x4*)(vst + (size_t)(tok0 + tid) * 32); float s1 = 0.f, s2 = 0.f;
#pragma unroll
            for (int k = 0; k < 8; ++k) { const f32x4 w = q[k]; s1 += w.x + w.z; s2 += w.y + w.w; }
            const float mean = s1 * (1.0f / DM), var = s2 * (1.0f / DM) - mean * mean;
            MR[tid] = (f32x2){mean, __builtin_amdgcn_rsqf(fmaxf(var, 0.f) + EPS)}; }
        const int variant = (h << 1) | (samp ? 1 : 0);
        if (variant != wm_variant) {
            f32x2 ww[16];
#pragma unroll
            for (int k = 0; k < 16; ++k) { const int idx = tid + 512 * k, i = idx >> 6, j2 = (idx & 63) * 2;
                ww[k] = *(const f32x2*)(wsp + (size_t)h * 16384 + (samp ? (i & 3) * 128 + (j2 & 3) : i * 128 + j2)); }
#pragma unroll
            for (int k = 0; k < 16; ++k) { const int idx = tid + 512 * k, i = idx >> 6, j2 = (idx & 63) * 2;
                bool k0, k1;
                if (!samp) { k0 = (j2 <= i); k1 = (j2 + 1 <= i); }
                else { const bool same = (i >> 2) == (j2 >> 2); const int ti = i & 3, tj = j2 & 3; k0 = same && tj <= ti; k1 = same && tj + 1 <= ti; }
                *(LAS unsigned*)(WmL + i * LD + j2) = cvt_pk_bf16(k0 ? ww[k].x : 0.f, k1 ? ww[k].y : 0.f); } }
        wm_variant = variant;
        __syncthreads();
#pragma unroll
        for (int k = 0; k < 4; ++k) { const int j = (tid + 512 * k) >> 4;
            const float* vp = zz + (size_t)(tok0 + j) * 2048 + 1024 + h * 128 + cp * 8;
            const f32x4 v0 = *(const f32x4*)vp, v1 = *(const f32x4*)(vp + 4); const f32x2 mr = MR[j];
            const f32x4 y0 = (v0 - mr.x) * mr.y * ga0 + ba0, y1 = (v1 - mr.x) * mr.y * ga1 + ba1;
            if (samp) { float* so = p->out + O_SC_S + (size_t)(tok0 + j - TP) * DM + h * 128 + cp * 8; *(f32x4*)so = y0; *(f32x4*)(so + 4) = y1; }
            const unsigned p0 = cvt_pk_bf16(y0.x, y0.y), p1 = cvt_pk_bf16(y0.z, y0.w), p2 = cvt_pk_bf16(y1.x, y1.y), p3 = cvt_pk_bf16(y1.z, y1.w);
            LAS bf16_t* d = VT + (cp * 8) * LD + j;
            d[0 * LD] = (bf16_t)(p0 & 0xffff); d[1 * LD] = (bf16_t)(p0 >> 16); d[2 * LD] = (bf16_t)(p1 & 0xffff); d[3 * LD] = (bf16_t)(p1 >> 16);
            d[4 * LD] = (bf16_t)(p2 & 0xffff); d[5 * LD] = (bf16_t)(p2 >> 16); d[6 * LD] = (bf16_t)(p3 & 0xffff); d[7 * LD] = (bf16_t)(p3 >> 16); }
        __syncthreads();
        const int i0 = 16 * wave, fr = lane & 15, fq = lane >> 4;
        f32x4 acc[8];
#pragma unroll
        for (int cb = 0; cb < 8; ++cb) acc[cb] = (f32x4){0.f, 0.f, 0.f, 0.f};
        const int nks = (i0 + 15) / 32 + 1;
        for (int ks = 0; ks < nks; ++ks) {
            const bf16x8 wf = *(const LAS bf16x8*)(WmL + (i0 + fr) * LD + ks * 32 + 8 * fq);
#pragma unroll
            for (int cb = 0; cb < 8; ++cb) { const bf16x8 vf = *(const LAS bf16x8*)(VT + (cb * 16 + fr) * LD + ks * 32 + 8 * fq);
                acc[cb] = __builtin_amdgcn_mfma_f32_16x16x32_bf16(vf, wf, acc[cb], 0, 0, 0); }
        }
        const int i = i0 + fr, tok = tok0 + i; const float bsv = bsp[h * 128 + (samp ? (i & 3) : i)];
#pragma unroll
        for (int cb = 0; cb < 8; ++cb) { const int col = h * 128 + cb * 16 + fq * 4;
            const f32x4 uu = *(const f32x4*)(zz + (size_t)tok * 2048 + col); const f32x4 y = uu * (acc[cb] + bsv);
            u32x2 o; o.x = cvt_pk_bf16(y.x, y.y); o.y = cvt_pk_bf16(y.z, y.w); *(u32x2*)(yb + (size_t)tok * DM + col) = o; }
        __syncthreads();
    }
    (void)hh;
}

__device__ __forceinline__ f32x4 bf4_to_f32(u32x2 v) { f32x4 r; r.x = __uint_as_float(v.x << 16); r.y = __uint_as_float(v.x & 0xffff0000u); r.z = __uint_as_float(v.y << 16); r.w = __uint_as_float(v.y & 0xffff0000u); return r; }
__device__ __forceinline__ void pool_token(KP p, const bf16_t* hbn, const float* SS, bf16_t* yb, int t, int lane) {
    const float* state_p = p->in[4];
    const int b = (t - TP) >> 2, s = (t - TP) & 3;
    u32x2* ob = (u32x2*)(yb + (size_t)t * DM) + lane;
    float rsd[4];
#pragma unroll
    for (int d = 0; d < 4; ++d) rsd[d] = (d <= s) ? pg8::row_rs(SS, t - (d <= s ? d : 0)) : 0.f;
#pragma unroll
    for (int j = 0; j < 4; ++j) {
        const int w = 2 << j; const f32x4 x0 = bf4_to_f32(((const u32x2*)(hbn + (size_t)t * DM) + lane)[64 * j]) * rsd[0]; f32x4 sum = x0;
#pragma unroll
        for (int d = 1; d < w; ++d) {
            if (d < 4) sum += bf4_to_f32(((const u32x2*)(hbn + (size_t)(t - (d <= s ? d : 0)) * DM) + lane)[64 * j]) * rsd[d];
            const int si = 15 + s - d;
            sum += ((const f32x4*)(state_p + ((size_t)b * 15 + (si > 14 ? 14 : si)) * DM) + lane)[64 * j] * ((d > s) ? 1.0f : 0.0f);
        }
        const f32x4 y = sum * (1.0f / (float)w) - x0;
        u32x2 o; o.x = cvt_pk_bf16(y.x, y.y); o.y = cvt_pk_bf16(y.z, y.w); ob[64 * j] = o;
    }
}
__device__ __forceinline__ void pool_state_rows(KP p, const bf16_t* hbn, const float* SS, int gw, int ngw, int lane) {
    const float* state_p = p->in[4];
    for (int it = gw; it < (8 + 128) * 15; it += ngw) {
        const float* src = nullptr; int tt = 0; float* dst;
        if (it < 120) { const int b = it / 15, r = it % 15; tt = b * 2048 + 2033 + r; dst = p->out + O_SP_P + (size_t)it * DM; }
        else { const int e = it - 120, b = e / 15, r = e % 15; if (r < 11) src = state_p + ((size_t)b * 15 + r + 4) * DM; else tt = TP + b * 4 + r - 11; dst = p->out + O_SP_S + (size_t)e * DM; }
        if (src) {
#pragma unroll
            for (int j = 0; j < 4; ++j) ((f32x4*)dst + lane)[64 * j] = ((const f32x4*)src + lane)[64 * j];
        } else { const float rs = pg8::row_rs(SS, tt);
#pragma unroll
            for (int j = 0; j < 4; ++j) ((f32x4*)dst + lane)[64 * j] = bf4_to_f32(((const u32x2*)(hbn + (size_t)tt * DM) + lane)[64 * j]) * rs; }
    }
}
__device__ __forceinline__ void pool_tile_prompt(const bf16_t* hbn, const float* SS, bf16_t* yb, LAS unsigned char* lds, int pm, int g, int tid) {
    LAS float* RS = (LAS float*)lds;
    const int t0 = pm * 256, sbase = (pm & 7) * 256;
    for (int k = tid; k < 271; k += NTHREADS) RS[k] = (sbase - 15 + k >= 0) ? pg8::row_rs(SS, t0 - 15 + k) : 0.f;
    __syncthreads();
    const int w = 2 << g, r0 = (tid >> 5) * 16; const size_t colb = (size_t)g * 256 + (tid & 31) * 8;
    f32x4 sa = (f32x4){0.f, 0.f, 0.f, 0.f}, sb = sa;
#define POOL_LDX(r_, a_, b_) do { const u32x4 v_ = *(const u32x4*)(hbn + (size_t)(t0 + (r_)) * DM + colb); const float rs_ = RS[(r_) + 15]; \
        a_ = bf4_to_f32((u32x2){v_.x, v_.y}) * rs_; b_ = bf4_to_f32((u32x2){v_.z, v_.w}) * rs_; } while (0)
    for (int d = 1; d < w; ++d) { const int r = r0 - d; if (sbase + r >= 0) { f32x4 a, b; POOL_LDX(r, a, b); sa += a; sb += b; } }
    for (int i = 0; i < 16; ++i) { const int r = r0 + i, s = sbase + r; f32x4 a, b; POOL_LDX(r, a, b); sa += a; sb += b;
        const float inv = 1.0f / (float)((s + 1 < w) ? s + 1 : w);
        const f32x4 ya = sa * inv - a, yc = sb * inv - b;
        u32x4 o; o.x = cvt_pk_bf16(ya.x, ya.y); o.y = cvt_pk_bf16(ya.z, ya.w); o.z = cvt_pk_bf16(yc.x, yc.y); o.w = cvt_pk_bf16(yc.z, yc.w);
        *(u32x4*)(yb + (size_t)(t0 + r) * DM + colb) = o;
        const int ro = r - w + 1; if (sbase + ro >= 0) { f32x4 a2, b2; POOL_LDX(ro, a2, b2); sa -= a2; sb -= b2; } }
#undef POOL_LDX
}

__global__ void __launch_bounds__(NTHREADS, 2) mega_fwd(Params p_unused) {
    extern __shared__ __attribute__((aligned(16))) unsigned char shm[];
    LAS unsigned char* lds = (LAS unsigned char*)shm;
    cg::grid_group grid = cg::this_grid();
    volatile LAS unsigned* st = (volatile LAS unsigned*)(lds + 131072);
    if (threadIdx.x == 0) { st[0] = 0u; st[1] = 0u; st[2] = 0u; st[3] = 0u; }
    __syncthreads();
    XcdBarrier bar;
#ifdef PROBE_CLASS
    unsigned long long pr_acc = 0, pr_t0 = __builtin_amdgcn_s_memrealtime();
#define PR_BEGIN() pr_t0 = __builtin_amdgcn_s_memrealtime()
#define PR_END(cond) do { if (cond) pr_acc += __builtin_amdgcn_s_memrealtime() - pr_t0; } while (0)
#else
#define PR_BEGIN()
#define PR_END(cond)
#endif
    {
        KP p = (KP)__builtin_amdgcn_kernarg_segment_ptr();
        const int tid = threadIdx.x, lane = tid & 63, wave = __builtin_amdgcn_readfirstlane(tid >> 6);
        const int G = gridDim.x, c = blockIdx.x, gw = c * NWAVES + wave, ngw = G * NWAVES;
        bar = xcd_barrier_post((unsigned*)(p->ws + WS_BAR), st);
        phase_prologue(p, lds, gw, ngw, wave, lane);
    }
    grid.sync();
    PR_END(PROBE_CLASS == 0);

#pragma unroll 1
    for (int ph = 0; ph < NLAYER * 11; ++ph) {
        KP p = (KP)__builtin_amdgcn_kernarg_segment_ptr(); asm volatile("" : "+s"(p));
        int G = gridDim.x, c = blockIdx.x; asm volatile("" : "+s"(G), "+s"(c));
#define PHASE_IDS() int tid = threadIdx.x; asm volatile("" : "+v"(tid)); const int lane = tid & 63, wave = __builtin_amdgcn_readfirstlane(tid >> 6), gw = c * NWAVES + wave, ngw = G * NWAVES; (void)lane; (void)wave; (void)gw; (void)ngw
        unsigned char* ws = p->ws;
        const int layer = ph / 11, step = ph % 11;
        float* h = p->out + O_Y;
        bf16_t* hb = (bf16_t*)(ws + WS_HB);
        bf16_t* act = (bf16_t*)(ws + WS_ACT);
        bf16_t* yb = (bf16_t*)(ws + WS_ACT);
        bf16_t* vn = (bf16_t*)(ws + WS_ACT + (size_t)NTOK * DM * 2);
        float* F = (float*)(ws + WS_F);
        float* FX = (float*)(ws + WS_FX);
        float* MT = (float*)(ws + WS_MT);
        float* SS = (float*)(ws + WS_SS);
        const float* g6 = p->in[5] + (size_t)layer * 6 * DM;
        int kind;
        switch (step) {
            case 0: case 8: kind = 1; break;
            case 1: case 9: case 6: kind = 9; break;
            case 2: case 7: case 10: kind = 0; break;
            case 3: kind = (layer == 0 || layer == 1) ? 1 : (layer == 2 ? 2 : 0); break;
            case 4: kind = (layer == 0) ? 4 : 0; break;
            default: kind = (layer == 1) ? 5 : (layer == 2 ? 7 : 0); break;
        }
        if (kind == 0) continue;
        PR_BEGIN();
        const int rstep = (step == 2 || step == 7 || step == 10) ? step - 1 : step;
        const float* gA = g6 + (rstep == 1 ? 1 : (rstep == 6 ? 3 : 5)) * DM;
        const float* gB = g6 + (rstep == 1 ? 2 : (rstep == 6 ? 4 : 6)) * DM;
        const float rscale = (rstep == 6) ? 1.0f : 0.5f;
        const int rlast = (layer == 3 && rstep == 9) ? 1 : 0;
        const int rns = (rstep == 6) ? ((layer == 3) ? 1 : 4) : 11;
        if (kind == 1) {
            pg8::Sched S; S.A = (const char*)hb; S.lda = DM; S.ldb = DM; S.K = DM; S.ns = 0; S.apn = 0; S.G = G; S.c = c; S.smode = 0;
            pg8::EpiGated E; E.SS = SS; E.pn_plain = 1 << 20; E.OF2 = nullptr; E.pub = nullptr;
            unsigned* pubcnt = (unsigned*)(ws + WS_CNT) + 48;
            if (step != 3) { S.Bt = (const char*)(ws + WS_W_FFN_IN + (size_t)(layer * 2 + (step == 8 ? 1 : 0)) * SZ_FFN_IN); S.nN = 22; E.O = act; E.OF = nullptr; E.ldo = DFF; E.mode = 0; S.smode = 1; E.pub = pubcnt; }
            else { S.Bt = (const char*)(ws + (layer == 0 ? WS_W_A_IN : WS_W_B_IN)); S.nN = 8; E.O = nullptr; E.OF = MT; E.ldo = DM; E.mode = (layer == 0) ? 1 : 2;
                if (layer == 1) { S.nN = 12; E.pn_plain = 8; E.OF2 = MT + (size_t)NTOK * DM; } }
#ifdef PROBE_CLASS
            pg8::gemm_phase(lds, S, E, (PROBE_CLASS == 6 && step != 3) ? (unsigned long long*)(ws + WS_BAR + 15360) : nullptr);
#else
            pg8::gemm_phase(lds, S, E);
#endif
            if (step == 3) { const int nextra = 66 * S.nN - 2 * 256 - (layer == 1 ? 256 : 0);
                if (c >= nextra) { PHASE_IDS(); convert_ffn_in_layer(p, layer + 1, lds, (c - nextra) * NWAVES + wave, (G - nextra) * NWAVES, wave, lane);
                    convert_mixer_weights(p, layer + 1, lds, (c - nextra) * NWAVES + wave, (G - nextra) * NWAVES, wave, lane);
                    if (layer == 0) { LAS float* scr = (LAS float*)(lds + wave * 16384); const int gwx = (c - nextra) * NWAVES + wave, ngwx = (G - nextra) * NWAVES;
                        for (int it = gwx; it < 16 * 176; it += ngwx) convert_matrix(p->in[6] + (size_t)1 * DM * 2 * DFF, DM, 2 * DFF, DFF, (bf16_t*)(ws + WS_W_FFN_IN + 1 * SZ_FFN_IN), it, scr, lane);
                        for (int it = gwx; it < 44 * 32; it += ngwx) convert_matrix(p->in[7] + (size_t)1 * DFF * DM, DFF, DM, 0, (bf16_t*)(ws + WS_W_FFN_DN + 1 * SZ_FFN_DN), it, scr, lane);
                        for (int it = gwx; it < 16 * 32; it += ngwx) convert_matrix(p->in[13], DM, DM, 0, (bf16_t*)(ws + WS_W_A_OUT), it, scr, lane); } } }
            if (step != 3 && c >= 172) {
                PHASE_IDS();
                if (tid == 0) { const unsigned want = 44u * (unsigned)(layer * 2 + (step == 8 ? 2 : 1)); unsigned sp = 0;
                    while (__hip_atomic_load(pubcnt, __ATOMIC_RELAXED, __HIP_MEMORY_SCOPE_AGENT) < want) { __builtin_amdgcn_s_sleep(1); if (++sp > (1u << 22)) break; }
                    __builtin_amdgcn_fence(__ATOMIC_ACQUIRE, "agent"); asm volatile("s_waitcnt vmcnt(0)" ::: "memory"); }
                __syncthreads();
                pg8::Sched S2; S2.A = (const char*)act; S2.Bt = (const char*)(ws + WS_W_FFN_DN + (size_t)(layer * 2 + (step == 8 ? 1 : 0)) * SZ_FFN_DN); S2.lda = DFF; S2.ldb = DFF; S2.nN = 4; S2.K = DFF; S2.ns = 11; S2.apn = 0;
                S2.G = 84; S2.c = c - 172; S2.smode = 3;
                pg8::EpiSlab E2; E2.F = F; E2.FX = FX; E2.SS = nullptr;
                pg8::gemm_phase(lds, S2, E2);
                if (ph == 0 && c >= 176) { LAS float* scr = (LAS float*)(lds + wave * 16384);
                    for (int it = (c - 176) * NWAVES + wave; it < 16 * 64; it += 80 * NWAVES) convert_matrix(p->in[8], DM, 2048, 1024, (bf16_t*)(ws + WS_W_A_IN), it, scr, lane); }
                if (layer < 3 && c >= 176) {
                    const int m = 2 * (layer + 1) + (step == 8 ? 1 : 0); LAS float* scr = (LAS float*)(lds + wave * 16384);
                    for (int it = (c - 176) * NWAVES + wave; it < 1280; it += 80 * NWAVES)
                        convert_matrix(p->in[7] + (size_t)m * DFF * DM, DFF, DM, 0, (bf16_t*)(ws + WS_W_FFN_DN + m * SZ_FFN_DN), it, scr, lane);
                }
            }
        } else if (kind == 2) {
            pg8::Sched S; S.G = G; S.c = c; S.apn = 0; S.ns = 0; S.A = (const char*)hb; S.lda = DM; S.ldb = DM; S.K = DM; S.smode = 0;
            pg8::EpiF32 E; E.SS = SS; E.vst = nullptr;
            if (step == 3) { S.Bt = (const char*)(ws + WS_W_C_IN); S.nN = 8; E.C = MT; E.ldc = 2048; E.act = 1; E.vst = (float*)vn; }
            else { S.Bt = (const char*)(ws + WS_W_B_IN + (size_t)2048 * DM * 2); S.nN = 4; E.C = MT + (size_t)NTOK * DM; E.ldc = DM; E.act = 0; }
            pg8::gemm_phase(lds, S, E);
            if (step == 3 && c >= 16) { PHASE_IDS(); convert_ffn_in_layer(p, layer + 1, lds, (c - 16) * NWAVES + wave, (G - 16) * NWAVES, wave, lane);
                convert_mixer_weights(p, layer + 1, lds, (c - 16) * NWAVES + wave, (G - 16) * NWAVES, wave, lane); }
        } else if (kind == 9) {
            pg8::Sched S; S.G = G; S.c = c; S.apn = 0; S.nN = 4; S.smode = (step != 6) ? 2 : 0;
            pg8::EpiResNorm E; E.h = h; E.hsrc = (ph == 1) ? p->in[0] : h; E.hb = hb; E.SS = SS; E.F = F; E.FX = FX; E.gA = gA; E.gB = gB; E.cscale = nullptr; E.scale = rscale; E.last = rlast;
            E.xbuf = (float*)(ws + WS_XBUF); E.cnt = (unsigned*)(ws + WS_CNT); E.tab = (LAS float*)(lds + LDS_TAB);
            E.target = 32u * (unsigned)(layer * 3 + (step == 1 ? 1 : (step == 6 ? 2 : 3)));
            if (step != 6) { S.A = (const char*)act; S.Bt = (const char*)(ws + WS_W_FFN_DN + (size_t)(layer * 2 + (step == 9 ? 1 : 0)) * SZ_FFN_DN); S.lda = DFF; S.ldb = DFF; S.K = DFF; S.ns = 11; }
            else { S.A = (const char*)(layer == 3 ? (bf16_t*)MT : yb); S.lda = DM;
                if (layer == 3) { S.Bt = (const char*)(ws + WS_W_D); S.ldb = 256; S.K = 256; S.ns = 1; S.apn = 256; E.cscale = p->in[24];
                    PHASE_IDS(); int pm0, pn0; pg8::map_tile(c, 64, 4, pm0, pn0);
                    pool_tile_prompt(hb, SS, (bf16_t*)MT, lds, pm0, pn0, tid);
                    pool_state_rows(p, hb, SS, gw, ngw, lane);
                    asm volatile("s_waitcnt vmcnt(0)" ::: "memory"); __syncthreads(); }
                else { S.Bt = (const char*)(ws + (layer == 0 ? WS_W_A_OUT : (layer == 1 ? WS_W_B_OUT : WS_W_C_OUT))); S.ldb = DM; S.K = DM; S.ns = 4; } }
#ifdef PROBE_CLASS
            pg8::gemm_phase(lds, S, E, (PROBE_CLASS == 7 && step != 6) ? (unsigned long long*)(ws + WS_BAR + 15360) : nullptr);
#else
            pg8::gemm_phase(lds, S, E);
#endif
            {
                PHASE_IDS();
                unsigned* cs = (unsigned*)(ws + WS_CNT) + 32;
                const unsigned starget = 32u * (unsigned)layer + (layer == 3 ? 8u : 32u);
                asm volatile("s_waitcnt vmcnt(0)" ::: "memory");
                __syncthreads();
                if (step == 6 && c < 8 * S.ns && tid == 0) { __builtin_amdgcn_fence(__ATOMIC_RELEASE, "agent"); asm volatile("s_waitcnt vmcnt(0)" ::: "memory"); __hip_atomic_fetch_add(cs, 1u, __ATOMIC_RELAXED, __HIP_MEMORY_SCOPE_AGENT); }
                if (c < 64) {
                    if (step == 6 && tid == 0) { unsigned sp = 0; while (__hip_atomic_load(cs, __ATOMIC_RELAXED, __HIP_MEMORY_SCOPE_AGENT) < starget) { __builtin_amdgcn_s_sleep(1); if (++sp > (1u << 22)) break; }
                        __builtin_amdgcn_fence(__ATOMIC_ACQUIRE, "agent"); asm volatile("s_waitcnt vmcnt(0)" ::: "memory"); }
                    __syncthreads();
                    phase_resnorm_sample(h, (ph == 1) ? p->in[1] - (size_t)TP * DM : h, F, FX, rns, rscale, gA, gB, hb, SS, rlast, gw, 512, lane);
                    if (layer == 3 && step == 1) {
                        asm volatile("s_waitcnt vmcnt(0)" ::: "memory"); __syncthreads();
                        pool_token(p, hb, SS, (bf16_t*)MT, TP + gw, lane);
                    }
                }
            }
        } else if (kind == 4) { PHASE_IDS(); phase_conv(p, MT, yb, lds, c, G, wave, lane); }
        else if (kind == 5) { PHASE_IDS(); phase_gate(p, MT, MT + (size_t)NTOK * DM, yb, gw, ngw, lane); }
        else if (kind == 7) { PHASE_IDS(); phase_spatial(p, MT, (const float*)vn, yb, lds, c, G, tid, wave, lane); }
        else { }
        PR_END((PROBE_CLASS == 1 && kind == 1 && step != 3) || (PROBE_CLASS == 2 && kind == 9 && step != 6) || (PROBE_CLASS == 4 && step >= 3 && step <= 6) || (PROBE_CLASS == 5 && kind == 3));
        PR_BEGIN();
        if (ph != NLAYER * 11 - 1) xcd_barrier(bar);
        PR_END(PROBE_CLASS == 3 || (PROBE_CLASS == 4 && step >= 3 && step <= 6));
    }
#ifdef PROBE_CLASS
    if (PROBE_CLASS >= 6) { pr_acc = *(volatile unsigned long long*)(((KP)__builtin_amdgcn_kernarg_segment_ptr())->ws + WS_BAR + 15360); }
    if (blockIdx.x == 0) { const unsigned long long t0 = __builtin_amdgcn_s_memrealtime(); while (__builtin_amdgcn_s_memrealtime() - t0 < pr_acc) __builtin_amdgcn_s_sleep(8); }
#endif
}

extern "C" void kernel_launch(void* const* d_in, const int* in_sizes, int n_in, void* d_out, int out_size, void* d_ws, size_t ws_size, hipStream_t stream) {
    static int grid = 0;
    if (grid == 0) {
        if (n_in != 25 || (size_t)out_size != O_END || ws_size < WS_END) { fprintf(stderr, "kernel_launch: unexpected shapes (n_in %d out %d ws %zu need %zu)\n", n_in, out_size, ws_size, (size_t)WS_END); grid = -1; return; }
        int dev = 0, cus = 0, per_cu = 0;
        hipGetDevice(&dev); hipDeviceGetAttribute(&cus, hipDeviceAttributeMultiprocessorCount, dev);
        hipFuncSetAttribute((const void*)mega_fwd, hipFuncAttributeMaxDynamicSharedMemorySize, LDS_BYTES);
        hipOccupancyMaxActiveBlocksPerMultiprocessor(&per_cu, (const void*)mega_fwd, NTHREADS, LDS_BYTES);
        if (per_cu < 1) { fprintf(stderr, "kernel_launch: occupancy query says %d blocks per CU\n", per_cu); per_cu = 1; }
        (void)hipGetLastError();
        grid = cus;
        if (grid != 256) fprintf(stderr, "kernel_launch: the fused epilogues assume 256 workgroups (got %d CUs)\n", grid);
    }
    if (grid < 0) return;
    hipMemsetAsync((char*)d_ws + WS_BAR, 0, 32768, stream);
    Params p{};
    for (int i = 0; i < 25; ++i) p.in[i] = (const float*)d_in[i];
    p.out = (float*)d_out; p.ws = (unsigned char*)d_ws;
    void* args[] = {&p};
    hipError_t e = hipLaunchCooperativeKernel((const void*)mega_fwd, dim3(grid), dim3(NTHREADS), args, LDS_BYTES, stream);
    if (e != hipSuccess) fprintf(stderr, "cooperative launch failed: %s (grid %d)\n", hipGetErrorString(e), grid);
}
```

```cpp
#include <hip/hip_runtime.h>
#include <hip/hip_cooperative_groups.h>
#include <cstdio>
#include <cstdint>
namespace cg = cooperative_groups;


#define LAS __attribute__((address_space(3)))
typedef unsigned short bf16_t;
typedef short bf16x8 __attribute__((ext_vector_type(8)));
typedef float f32x4 __attribute__((ext_vector_type(4)));
typedef float f32x2 __attribute__((ext_vector_type(2)));
typedef unsigned u32x4 __attribute__((ext_vector_type(4)));
typedef unsigned u32x2 __attribute__((ext_vector_type(2)));

constexpr int DM = 1024, DFF = 2816, TP = 16384, TS = 512, NTOK = TP + TS, NLAYER = 4;
constexpr float EPS = 1e-6f;
constexpr int NTHREADS = 512, NWAVES = 8;

constexpr size_t O_Y = 0;
constexpr size_t O_SA_P = (size_t)NTOK * DM;
constexpr size_t O_SA_S = O_SA_P + (size_t)8 * 30 * DM;
constexpr size_t O_SB_P = O_SA_S + (size_t)128 * 30 * DM;
constexpr size_t O_SB_S = O_SB_P + (size_t)8 * 2 * DM;
constexpr size_t O_SC_S = O_SB_S + (size_t)128 * 2 * DM;
constexpr size_t O_SP_P = O_SC_S + (size_t)128 * 4 * DM;
constexpr size_t O_SP_S = O_SP_P + (size_t)8 * 15 * DM;
constexpr size_t O_END = O_SP_S + (size_t)128 * 15 * DM;

constexpr size_t WS_BAR = 0;
constexpr size_t WS_CNT = 16384;
constexpr size_t WS_XBUF = 32768;
constexpr size_t WS_SS = WS_XBUF + (size_t)64 * 256 * 4 * 4;
constexpr size_t WS_W_FFN_IN = WS_SS + (size_t)NTOK * 4 * 4;
constexpr size_t SZ_FFN_IN = (size_t)2 * DFF * DM * 2;
constexpr size_t WS_W_FFN_DN = WS_W_FFN_IN + 8 * SZ_FFN_IN;
constexpr size_t SZ_FFN_DN = (size_t)DM * DFF * 2;
constexpr size_t WS_W_A_IN = WS_W_FFN_DN + 8 * SZ_FFN_DN;
constexpr size_t WS_W_A_OUT = WS_W_A_IN + (size_t)2048 * 1024 * 2;
constexpr size_t WS_W_B_IN = WS_W_A_OUT + (size_t)1024 * 1024 * 2;
constexpr size_t WS_W_B_OUT = WS_W_B_IN + (size_t)3072 * 1024 * 2;
constexpr size_t WS_W_C_IN = WS_W_B_OUT + (size_t)1024 * 1024 * 2;
constexpr size_t WS_W_C_OUT = WS_W_C_IN + (size_t)2048 * 1024 * 2;
constexpr size_t WS_W_D = WS_W_C_OUT + (size_t)1024 * 1024 * 2;
constexpr size_t WS_HB = WS_W_D + (size_t)1024 * 256 * 2;
constexpr size_t WS_ACT = WS_HB + (size_t)NTOK * DM * 2;
constexpr size_t WS_F = WS_ACT + (size_t)NTOK * DFF * 2;
constexpr size_t WS_FX = WS_F + (size_t)NTOK * DM * 4;
constexpr size_t WS_MT = WS_FX + (size_t)10 * TS * DM * 4;
constexpr size_t WS_END = WS_MT + (size_t)NTOK * 3072 * 4;

constexpr int LDS_TAB = 131072 + 64;
constexpr int LDS_BYTES = LDS_TAB + 5120 + 64;

struct Params { const float* in[25]; float* out; unsigned char* ws; };
typedef const Params __attribute__((address_space(4)))* KP;

__device__ __forceinline__ unsigned cvt_pk_bf16(float lo, float hi) { unsigned r; asm volatile("v_cvt_pk_bf16_f32 %0, %1, %2" : "=v"(r) : "v"(lo), "v"(hi)); return r; }
__device__ __forceinline__ float wave_sum(float v) {
#pragma unroll
    for (int o = 1; o < 64; o <<= 1) v += __shfl_xor(v, o);
    return v;
}
__device__ __forceinline__ float sigmoid_f(float x) { return __builtin_amdgcn_rcpf(1.0f + __expf(-x)); }
__device__ __forceinline__ f32x2 gelu_pk(f32x2 v) {
    const f32x2 av = __builtin_elementwise_abs(v), d = av * 0.2316418882f + 1.0f;
    f32x2 t; t.x = __builtin_amdgcn_rcpf(d.x); t.y = __builtin_amdgcn_rcpf(d.y);
    f32x2 q = t * 0.5307027145f + (-0.7265760135f); q = q * t + 0.7107068705f; q = q * t + (-0.142248368f); q = q * t + 0.127414796f; q = q * t;
    const f32x2 s = (v * v) * (-0.72134752044f);
    f32x2 e; e.x = __builtin_amdgcn_exp2f(s.x); e.y = __builtin_amdgcn_exp2f(s.y);
    const f32x2 m = v * (q * e), r = v - m;
    f32x2 o; o.x = v.x < 0.f ? m.x : r.x; o.y = v.y < 0.f ? m.y : r.y; return o;
}

#define XB_TMO      128
#define XB_XCNT(j)  (256  + 64 * (j))
#define XB_XSUB(j)  (1280 + 64 * (j))
#define XB_XGEN(j)  (2304 + 64 * (j))
#define XB_TOP      3328
#define XB_TOPGEN   3392
#define XCD_BAR_WORDS 3456
#define XB_SPIN_CAP (1u << 20)
__device__ __forceinline__ unsigned xb_ld(unsigned* p)              { return __hip_atomic_load(p, __ATOMIC_RELAXED, __HIP_MEMORY_SCOPE_AGENT); }
__device__ __forceinline__ unsigned xb_add(unsigned* p, unsigned v) { return __hip_atomic_fetch_add(p, v, __ATOMIC_RELAXED, __HIP_MEMORY_SCOPE_AGENT); }
__device__ __forceinline__ unsigned xb_xcc_id() { return (unsigned)__builtin_amdgcn_s_getreg((3 << 11) | 20) & 0xFu; }
#define XB_SPIN(cond, bar) do { unsigned _sp = 0; while (cond) { __builtin_amdgcn_s_sleep(1); \
    if ((++_sp & 255u) == 0u) { if (xb_ld(&(bar)[XB_TMO])) break; if (_sp > XB_SPIN_CAP) { atomicAdd(&(bar)[XB_TMO], 1u); break; } } } } while (0)
struct XcdBarrier { unsigned* bar; unsigned x; volatile LAS unsigned* st; };
__device__ __forceinline__ XcdBarrier xcd_barrier_post(unsigned* bar, volatile LAS unsigned* st) {
    XcdBarrier b; b.bar = bar; b.x = xb_xcc_id(); b.st = st;
    if (threadIdx.x == 0) (void)xb_add(&bar[XB_XCNT(b.x)], 1u);
    return b;
}
__device__ __forceinline__ void xcd_barrier_complete(unsigned* bar, unsigned x, unsigned& nloc, unsigned& nx) {
    const unsigned G = gridDim.x * gridDim.y * gridDim.z;
    unsigned sum, cnt, mine, sp = 0u;
    for (;;) {
        sum = 0u; cnt = 0u; mine = 0u;
#pragma unroll
        for (unsigned j = 0; j < 16; ++j) { const unsigned c = xb_ld(&bar[XB_XCNT(j)]); sum += c; cnt += (c > 0u) ? 1u : 0u; mine = (j == x) ? c : mine; }
        if (sum == G) break;
        __builtin_amdgcn_s_sleep(1);
        if ((++sp & 255u) == 0u) { if (xb_ld(&bar[XB_TMO])) break; if (sp > XB_SPIN_CAP) { atomicAdd(&bar[XB_TMO], 1u); break; } }
    }
    nloc = mine > 0u ? mine : 1u; nx = cnt > 0u ? cnt : 1u;
}
__device__ __forceinline__ void xcd_barrier(const XcdBarrier& b) {
    asm volatile("s_waitcnt vmcnt(0)" ::: "memory");
    __syncthreads();
    if (threadIdx.x == 0) {
        unsigned* bar = b.bar;
        __builtin_amdgcn_s_waitcnt(0);
        unsigned nloc = b.st[0], nx = b.st[1];
        if (nloc == 0u) { xcd_barrier_complete(bar, b.x, nloc, nx); b.st[0] = nloc; b.st[1] = nx; }
        const unsigned old = xb_add(&bar[XB_XSUB(b.x)], 1u);
        const unsigned gen = old / nloc;
        if (old + 1u == (gen + 1u) * nloc) {
            __builtin_amdgcn_fence(__ATOMIC_RELEASE, "agent");
            asm volatile("s_waitcnt vmcnt(0)" ::: "memory");
            const unsigned og = xb_add(&bar[XB_TOP], 1u);
            const unsigned tg = og / nx;
            if (og + 1u == (tg + 1u) * nx) xb_add(&bar[XB_TOPGEN], 1u);
            else XB_SPIN(xb_ld(&bar[XB_TOPGEN]) == tg, bar);
            __builtin_amdgcn_fence(__ATOMIC_ACQUIRE, "agent");
            xb_add(&bar[XB_XGEN(b.x)], 1u);
            asm volatile("s_waitcnt vmcnt(0)" ::: "memory");
        } else {
            XB_SPIN(xb_ld(&bar[XB_XGEN(b.x)]) == gen, bar);
            __builtin_amdgcn_fence(__ATOMIC_ACQUIRE, "agent");
            asm volatile("s_waitcnt vmcnt(0)" ::: "memory");
        }
    }
    __syncthreads();
}

namespace pg8 {
constexpr int BM = 256, BK = 64, HALF = 128, HTB = HALF * BK * 2, STAGE_BYTES = 8 * HTB, NXCD = 8, WGM = 8;
__device__ __forceinline__ int lds_byte(int r, int c) { const int st = (r >> 4) * 2 + (c >> 5), rr = r & 15, cc = c & 31, ob = rr * 64 + cc * 2; return st * 1024 + (ob ^ (((ob >> 9) & 1) << 5)); }
__device__ __forceinline__ void stage_rc(int b, int& R, int& C) { const int st = b / 1024, sb = b % 1024, swz = sb ^ (((sb >> 9) & 1) << 5); R = (st >> 1) * 16 + swz / 64; C = (st & 1) * 32 + (swz % 64) / 2; }
__device__ __forceinline__ int perm32(int rho) { const int n = rho >> 4, i = rho & 15; return 8 * (i >> 2) + 4 * n + (i & 3); }

struct Unit { const char* a; const char* b; int pm, pn, z, nt; };

__device__ __forceinline__ void map_tile(int L, int nM, int nN, int& pm, int& pn) {
    const int nwg = nM * nN; int wgid = L;
    { const int q = nwg / NXCD, r = nwg % NXCD, xcd = wgid % NXCD, off = wgid / NXCD; wgid = (xcd < r ? xcd * (q + 1) : r * (q + 1) + (xcd - r) * q) + off; }
    const int nig = WGM * nN, gid = wgid / nig, fm = gid * WGM, gsz = (nM - fm) < WGM ? (nM - fm) : WGM;
    pm = fm + ((wgid % nig) % gsz); pn = (wgid % nig) / gsz;
}

struct Sched {
    const char* A; const char* Bt; int lda, ldb, nN, K, ns, apn, G, c, smode;
    __device__ __forceinline__ bool next(int i, Unit& u) const {
        const int L = i * G + c; int pm, pn, z = 0, nt;
        if (smode == 1) { if (L >= 66 * nN) return false; if (L < 2 * nN) { pm = 64 + (L & 1); pn = L >> 1; } else map_tile(L - 2 * nN, 64, nN, pm, pn); nt = K >> 6; }
        else if (smode == 2) { if (L >= 64 * nN) return false; map_tile(L, 64, nN, pm, pn); nt = K >> 6; }
        else if (smode == 3) { if (L >= 2 * nN * ns) return false; z = L / (2 * nN); const int r = L % (2 * nN); pm = 64 + r / nN; pn = r % nN; nt = (K / ns) >> 6; }
        else if (ns == 0) { if (L >= 66 * nN) return false; map_tile(L, 66, nN, pm, pn); nt = K >> 6; }
        else if (L < 64 * nN) { map_tile(L, 64, nN, pm, pn); nt = K >> 6; }
        else { const int e = L - 64 * nN; if (e >= 2 * nN * ns) return false; z = e / (2 * nN); const int r = e % (2 * nN); pm = 64 + r / nN; pn = r % nN; nt = (K / ns) >> 6; }
        const int ksub = nt * 64;
        u.a = A + ((size_t)pm * 256 * lda + (size_t)pn * apn + (size_t)z * ksub) * 2;
        u.b = Bt + ((size_t)pn * 256 * ldb + (size_t)z * ksub) * 2;
        u.pm = pm; u.pn = pn; u.z = z; u.nt = nt; return true;
    }
};

__device__ __forceinline__ float row_rs(const float* SS, int row) { const f32x4 q = *(const f32x4*)(SS + (size_t)row * 4); return __builtin_amdgcn_rsqf(((q.x + q.y) + (q.z + q.w)) * (1.0f / DM) + EPS); }

struct EpiF32 {
    static constexpr bool PERM = false;
    static constexpr bool USE_RS = true;
    float* C; int ldc; int act; const float* SS; float* vst;
    __device__ __forceinline__ void operator()(f32x4 (&acc)[2][2][4][2], const Unit& u, int wr, int wc, int fr, int fq, const LAS float* rstab) const {
        const int row0 = u.pm * BM + wr * 64 + fr, col0 = u.pn * BM + wc * 32 + 4 * fq;
        const bool stats = (vst != nullptr) && (u.pn >= 4);
        float rsv[2][4];
#pragma unroll
        for (int ai = 0; ai < 2; ++ai)
#pragma unroll
            for (int m = 0; m < 4; ++m) rsv[ai][m] = rstab[ai * HALF + wr * 64 + m * 16 + fr];
#pragma unroll
        for (int ai = 0; ai < 2; ++ai)
#pragma unroll
            for (int m = 0; m < 4; ++m) { const int row = row0 + ai * HALF + m * 16; const float rs = rsv[ai][m]; float* rowp = C + (size_t)row * ldc + col0; float s1 = 0.f, s2 = 0.f;
#pragma unroll
                for (int bj = 0; bj < 2; ++bj)
#pragma unroll
                    for (int n = 0; n < 2; ++n) { f32x4 v = acc[ai][bj][m][n] * rs;
                        if (act) { const f32x2 a = gelu_pk((f32x2){v[0], v[1]}), b = gelu_pk((f32x2){v[2], v[3]}); v = (f32x4){a.x, a.y, b.x, b.y}; }
                        s1 += (v[0] + v[1]) + (v[2] + v[3]); s2 += (v[0] * v[0] + v[1] * v[1]) + (v[2] * v[2] + v[3] * v[3]);
                        *(f32x4*)(rowp + bj * HALF + n * 16) = v; }
                if (stats) { s1 += __shfl_xor(s1, 16); s1 += __shfl_xor(s1, 32); s2 += __shfl_xor(s2, 16); s2 += __shfl_xor(s2, 32);
                    if (fq == 0) *(f32x2*)(vst + ((size_t)row * 16 + (u.pn - 4) * 4 + wc) * 2) = (f32x2){s1, s2}; } }
    }
};
struct EpiGated {
    static constexpr bool PERM = true;
    static constexpr bool USE_RS = true;
    bf16_t* O; float* OF; int ldo; int mode; const float* SS; int pn_plain; float* OF2; unsigned* pub;
    __device__ __forceinline__ void operator()(f32x4 (&acc)[2][2][4][2], const Unit& u, int wr, int wc, int fr, int fq, const LAS float* rstab) const {
        const int row0 = u.pm * BM + wr * 64 + fr, col0 = u.pn * HALF + wc * 32 + 8 * fq;
        float rs[2][4];
#pragma unroll
        for (int ai = 0; ai < 2; ++ai)
#pragma unroll
            for (int m = 0; m < 4; ++m) rs[ai][m] = rstab[ai * HALF + wr * 64 + m * 16 + fr];
        if (u.pn >= pn_plain) {
            const int c0 = (u.pn - pn_plain) * BM + wc * 32 + 8 * fq;
#pragma unroll
            for (int ai = 0; ai < 2; ++ai)
#pragma unroll
                for (int m = 0; m < 4; ++m) { float* rowp = OF2 + (size_t)(row0 + ai * HALF + m * 16) * DM + c0; const float r1 = rs[ai][m];
#pragma unroll
                    for (int bj = 0; bj < 2; ++bj)
#pragma unroll
                        for (int n = 0; n < 2; ++n) *(f32x4*)(rowp + bj * HALF + 4 * n) = acc[ai][bj][m][n] * r1; }
        } else if (mode == 0) {
#pragma unroll
            for (int ai = 0; ai < 2; ++ai)
#pragma unroll
                for (int m = 0; m < 4; ++m) { const size_t off = (size_t)(row0 + ai * HALF + m * 16) * ldo + col0; const float r1 = rs[ai][m], r2 = r1 * (-1.44269504f);
                    f32x4 r[2];
#pragma unroll
                    for (int n = 0; n < 2; ++n) { const f32x4 p = acc[ai][0][m][n], q = acc[ai][1][m][n];
#pragma unroll
                        for (int j = 0; j < 4; ++j) { const float e = __builtin_amdgcn_exp2f(p[j] * r2); r[n][j] = (p[j] * r1) * (q[j] * r1) * __builtin_amdgcn_rcpf(1.0f + e); } }
                    u32x4 w; w.x = cvt_pk_bf16(r[0][0], r[0][1]); w.y = cvt_pk_bf16(r[0][2], r[0][3]); w.z = cvt_pk_bf16(r[1][0], r[1][1]); w.w = cvt_pk_bf16(r[1][2], r[1][3]); *(u32x4*)(O + off) = w; }
        } else if (mode == 1) {
#pragma unroll
            for (int ai = 0; ai < 2; ++ai)
#pragma unroll
                for (int m = 0; m < 4; ++m) { const size_t off = (size_t)(row0 + ai * HALF + m * 16) * ldo + col0; const float r1 = rs[ai][m], r2 = r1 * (-1.44269504f);
#pragma unroll
                    for (int n = 0; n < 2; ++n) { const f32x4 p = acc[ai][0][m][n], q = acc[ai][1][m][n]; f32x4 r;
#pragma unroll
                        for (int j = 0; j < 4; ++j) { const float e = __builtin_amdgcn_exp2f(q[j] * r2); r[j] = (p[j] * r1) * __builtin_amdgcn_rcpf(1.0f + e); }
                        *(f32x4*)(OF + off + 4 * n) = r; } }
        } else {
#pragma unroll
            for (int ai = 0; ai < 2; ++ai)
#pragma unroll
                for (int m = 0; m < 4; ++m) { const size_t off = (size_t)(row0 + ai * HALF + m * 16) * ldo + col0; const float r1 = rs[ai][m] * rs[ai][m];
#pragma unroll
                    for (int n = 0; n < 2; ++n) *(f32x4*)(OF + off + 4 * n) = acc[ai][0][m][n] * acc[ai][1][m][n] * r1; }
        }
        if (pub && u.pm >= 64) {
            asm volatile("s_waitcnt vmcnt(0)" ::: "memory"); __builtin_amdgcn_s_barrier(); asm volatile("" ::: "memory");
            if (threadIdx.x == 0) { __builtin_amdgcn_fence(__ATOMIC_RELEASE, "agent"); asm volatile("s_waitcnt vmcnt(0)" ::: "memory"); __hip_atomic_fetch_add(pub, 1u, __ATOMIC_RELAXED, __HIP_MEMORY_SCOPE_AGENT); }
        }
    }
};
struct EpiSlab {
    static constexpr bool PERM = false;
    static constexpr bool USE_RS = false;
    float* F; float* FX; const float* SS;
    __device__ __forceinline__ void operator()(f32x4 (&acc)[2][2][4][2], const Unit& u, int wr, int wc, int fr, int fq, const LAS float*) const {
        const int row0 = u.pm * BM + wr * 64 + fr, col0 = u.pn * BM + wc * 32 + 4 * fq;
        float* base = (u.z == 0) ? F + (size_t)row0 * DM : FX + ((size_t)(u.z - 1) * TS + (row0 - TP)) * DM;
#pragma unroll
        for (int ai = 0; ai < 2; ++ai)
#pragma unroll
            for (int m = 0; m < 4; ++m) { float* rowp = base + (size_t)(ai * HALF + m * 16) * DM + col0;
#pragma unroll
                for (int bj = 0; bj < 2; ++bj)
#pragma unroll
                    for (int n = 0; n < 2; ++n) *(f32x4*)(rowp + bj * HALF + n * 16) = acc[ai][bj][m][n]; }
    }
};
struct EpiResNorm {
    static constexpr bool PERM = true;
    static constexpr bool USE_RS = false;
    float* h; const float* hsrc; bf16_t* hb; float* SS; float* F; float* FX; const float* gA; const float* gB; const float* cscale; float scale; int last;
    float* xbuf; unsigned* cnt; unsigned target; LAS float* tab;
    __device__ __forceinline__ void operator()(f32x4 (&acc)[2][2][4][2], const Unit& u, int wr_, int wc_, int fr_, int fq_, const LAS float*) const {
        int tid = threadIdx.x; asm volatile("" : "+v"(tid));
        const int lane = tid & 63, wid = __builtin_amdgcn_readfirstlane(tid >> 6), wr = wid >> 2, wc = wid & 3, fr = lane & 15, fq = lane >> 4;
        (void)wr_; (void)wc_; (void)fr_; (void)fq_;
        const int col0 = u.pn * BM + wc * 32 + 8 * fq;
        if (cscale) {
#pragma unroll
            for (int bj = 0; bj < 2; ++bj)
#pragma unroll
                for (int n = 0; n < 2; ++n) { const f32x4 sv = *(const f32x4*)(cscale + col0 + bj * HALF + n * 4);
#pragma unroll
                    for (int ai = 0; ai < 2; ++ai)
#pragma unroll
                        for (int m = 0; m < 4; ++m) acc[ai][bj][m][n] *= sv; }
        }
        if (u.pm >= 64) {
            const int row0 = u.pm * BM + wr * 64 + fr;
            float* base = (u.z == 0) ? F + (size_t)row0 * DM : FX + ((size_t)(u.z - 1) * TS + (row0 - TP)) * DM;
#pragma unroll
            for (int ai = 0; ai < 2; ++ai)
#pragma unroll
                for (int m = 0; m < 4; ++m) { float* rowp = base + (size_t)(ai * HALF + m * 16) * DM + col0;
#pragma unroll
                    for (int bj = 0; bj < 2; ++bj)
#pragma unroll
                        for (int n = 0; n < 2; ++n) *(f32x4*)(rowp + bj * HALF + n * 4) = acc[ai][bj][m][n]; }
            return;
        }
        LAS float* P = tab; LAS float* S = tab + 1024;
        f32x4 hbuf[2][4], gav[4], gbv[4];
        { const size_t off0 = (size_t)(u.pm * BM + wr * 64 + fr) * DM + col0;
#pragma unroll
            for (int q = 0; q < 4; ++q) { const int cc = (q >> 1) * HALF + (q & 1) * 4; hbuf[0][q] = *(const f32x4*)(hsrc + off0 + cc); gav[q] = *(const f32x4*)(gA + col0 + cc); gbv[q] = last ? (f32x4){0.f, 0.f, 0.f, 0.f} : *(const f32x4*)(gB + col0 + cc); } }
        f32x4 warm = (f32x4){0.f, 0.f, 0.f, 0.f};
#pragma unroll 1
        for (int g = 1; g < 8; ++g) { const float* hp = hsrc + (size_t)(u.pm * BM + (g >> 2) * HALF + wr * 64 + (g & 3) * 16 + fr) * DM + col0;
            asm volatile("global_load_dwordx4 %0, %1, off\n\tglobal_load_dwordx4 %0, %1, off offset:16\n\tglobal_load_dwordx4 %0, %1, off offset:512\n\tglobal_load_dwordx4 %0, %1, off offset:528" : "+v"(warm) : "v"(hp) : "memory"); }
#pragma unroll
        for (int ai = 0; ai < 2; ++ai)
#pragma unroll
            for (int m = 0; m < 4; ++m) { float s = 0.f;
#pragma unroll
                for (int bj = 0; bj < 2; ++bj)
#pragma unroll
                    for (int n = 0; n < 2; ++n) { const f32x4 x = acc[ai][bj][m][n]; s += (x[0] * x[0] + x[1] * x[1]) + (x[2] * x[2] + x[3] * x[3]); }
                s += __shfl_xor(s, 16); s += __shfl_xor(s, 32);
                if (fq == 0) P[(ai * HALF + wr * 64 + m * 16 + fr) * 4 + wc] = s; }
        asm volatile("s_waitcnt lgkmcnt(0)" ::: "memory"); __builtin_amdgcn_s_barrier(); asm volatile("" ::: "memory");
        const int row = wid * 32 + (lane & 31);
        if (lane < 32) { const f32x4 pp = *(const LAS f32x4*)(P + row * 4);
            __hip_atomic_store(xbuf + ((size_t)(u.pm * BM + row) * 4 + u.pn), (pp.x + pp.y) + (pp.z + pp.w), __ATOMIC_RELAXED, __HIP_MEMORY_SCOPE_AGENT); }
        asm volatile("s_waitcnt vmcnt(0)" : "+v"(warm) :: "memory");
        if (lane == 0) __hip_atomic_fetch_add(cnt + 64 * u.pm, 1u, __ATOMIC_RELAXED, __HIP_MEMORY_SCOPE_AGENT);
        if (wid == 0) {
            unsigned sp = 0;
            while ((unsigned)__builtin_amdgcn_readfirstlane(__hip_atomic_load(cnt + 64 * u.pm, __ATOMIC_RELAXED, __HIP_MEMORY_SCOPE_AGENT)) < target) { __builtin_amdgcn_s_sleep(1); if (++sp > (1u << 22)) break; }
            __builtin_amdgcn_fence(__ATOMIC_ACQUIRE, "agent");
        }
        asm volatile("s_waitcnt vmcnt(0) lgkmcnt(0)" ::: "memory"); __builtin_amdgcn_s_barrier(); asm volatile("" ::: "memory");
        if (lane < 32) { const float* slot = xbuf + (size_t)(u.pm * BM + row) * 4; float tot = 0.f;
#pragma unroll
            for (int t = 0; t < 4; ++t) tot += __hip_atomic_load(slot + t, __ATOMIC_RELAXED, __HIP_MEMORY_SCOPE_AGENT);
            S[row] = scale * __builtin_amdgcn_rsqf(tot * (1.0f / DM) + EPS); }
        asm volatile("s_waitcnt vmcnt(0) lgkmcnt(0)" ::: "memory"); __builtin_amdgcn_s_barrier(); asm volatile("" ::: "memory");
#pragma unroll
        for (int g = 0; g < 8; ++g) { const int ai = g >> 2, m = g & 3;
            if (g + 1 < 8) { const int ai2 = (g + 1) >> 2, m2 = (g + 1) & 3; const size_t off2 = (size_t)(u.pm * BM + ai2 * HALF + wr * 64 + m2 * 16 + fr) * DM + col0;
#pragma unroll
                for (int q = 0; q < 4; ++q) hbuf[(g + 1) & 1][q] = *(const f32x4*)(hsrc + off2 + (q >> 1) * HALF + (q & 1) * 4); }
            asm volatile("" ::: "memory");
            const int r = ai * HALF + wr * 64 + m * 16 + fr; const float rs = S[r]; const size_t off = (size_t)(u.pm * BM + r) * DM + col0; float s2 = 0.f;
#pragma unroll
            for (int bj = 0; bj < 2; ++bj) { u32x4 w4;
#pragma unroll
                for (int n = 0; n < 2; ++n) { const int q = 2 * bj + n, cc = bj * HALF + n * 4;
                    const f32x4 hv = hbuf[g & 1][q] + acc[ai][bj][m][n] * rs * gav[q]; *(f32x4*)(h + off + cc) = hv;
                    s2 += (hv[0] * hv[0] + hv[1] * hv[1]) + (hv[2] * hv[2] + hv[3] * hv[3]);
                    const f32x4 x = hv * gbv[q]; if (n == 0) { w4.x = cvt_pk_bf16(x[0], x[1]); w4.y = cvt_pk_bf16(x[2], x[3]); } else { w4.z = cvt_pk_bf16(x[0], x[1]); w4.w = cvt_pk_bf16(x[2], x[3]); } }
                if (!last) *(u32x4*)(hb + off + bj * HALF) = w4; }
            s2 += __shfl_xor(s2, 16); s2 += __shfl_xor(s2, 32);
            if (fq == 0) P[r * 4 + wc] = s2;
            asm volatile("" ::: "memory"); }
        asm volatile("s_waitcnt lgkmcnt(0)" ::: "memory"); __builtin_amdgcn_s_barrier(); asm volatile("" ::: "memory");
        if (lane < 32) { const f32x4 pp = *(const LAS f32x4*)(P + row * 4); SS[(size_t)(u.pm * BM + row) * 4 + u.pn] = (pp.x + pp.y) + (pp.z + pp.w); }
        asm volatile("s_waitcnt lgkmcnt(0)" ::: "memory"); __builtin_amdgcn_s_barrier(); asm volatile("" ::: "memory");
    }
};

template <class Epi>
__device__ __forceinline__ void gemm_phase(LAS unsigned char* lds, const Sched& S, const Epi& E, unsigned long long* probe = nullptr) {
    int tid = threadIdx.x; asm volatile("" : "+v"(tid));
    const int wid = __builtin_amdgcn_readfirstlane(tid >> 6), lane = tid & 63, wr = wid >> 2, wc = wid & 3, fr = lane & 15, fq = lane >> 4;
    const int lda = S.lda, ldb = S.ldb;
    unsigned voffA[2], voffB[2];
#pragma unroll
    for (int i = 0; i < 2; ++i) { int R, C; stage_rc(tid * 16 + i * 8192, R, C); const int Rb = Epi::PERM ? ((R & ~31) + perm32(R & 31)) : R;
        voffA[i] = (unsigned)(R * lda + C) * 2u; voffB[i] = (unsigned)(Rb * ldb + C) * 2u; }
    const size_t kstep = (size_t)(BK * 2);
    const size_t hstepA = (size_t)HALF * lda * 2, hstepB = (size_t)HALF * ldb * 2;
    const unsigned ldsw = (unsigned)wid * 1024u;
    const int aoff = lds_byte(wr * 64 + fr, fq * 8), boff = lds_byte(wc * 32 + fr, fq * 8);
#define PG8_SA(b, h) (((b) * 2 + (h)) * HTB)
#define PG8_SB(b, h) ((4 + (b) * 2 + (h)) * HTB)
#define PG8_STAGE(bufoff, gbase, voff) do { _Pragma("unroll") for (int _i = 0; _i < 2; ++_i) \
        __builtin_amdgcn_global_load_lds((const unsigned*)((const char*)(gbase) + (voff)[_i]), (LAS unsigned*)(lds + (bufoff) + ldsw + _i * 8192), 16, 0, 0); } while (0)
#define PG8_LDA(dst, b, h) do { _Pragma("unroll") for (int m = 0; m < 4; ++m) _Pragma("unroll") for (int k = 0; k < 2; ++k) dst[m][k] = *(const LAS bf16x8*)(lds + PG8_SA(b, h) + aoff + m * 2048 + k * 1024); } while (0)
#define PG8_LDB(dst, b, h) do { _Pragma("unroll") for (int n = 0; n < 2; ++n) _Pragma("unroll") for (int k = 0; k < 2; ++k) dst[n][k] = *(const LAS bf16x8*)(lds + PG8_SB(b, h) + boff + n * 2048 + k * 1024); } while (0)
#define PG8_MMA(ai, bj, At, Bt) do { __builtin_amdgcn_s_setprio(1); _Pragma("unroll") for (int m = 0; m < 4; ++m) _Pragma("unroll") for (int n = 0; n < 2; ++n) _Pragma("unroll") for (int k = 0; k < 2; ++k) \
        acc[ai][bj][m][n] = __builtin_amdgcn_mfma_f32_16x16x32_bf16(Bt[n][k], At[m][k], acc[ai][bj][m][n], 0, 0, 0); __builtin_amdgcn_s_setprio(0); } while (0)
#define PG8_WAIT_V(n) asm volatile("s_waitcnt vmcnt(" #n ")" ::: "memory")
#define PG8_WAIT_L(n) asm volatile("s_waitcnt lgkmcnt(" #n ")" ::: "memory")
#define PG8_BAR __builtin_amdgcn_s_barrier()
#define PG8_SCHED __builtin_amdgcn_sched_barrier(0)
    Unit cur, nxt; int ui = 0;
    if (!S.next(0, cur)) return;
    f32x4 acc[2][2][4][2];
#pragma unroll
    for (int a = 0; a < 2; ++a)
#pragma unroll
        for (int b = 0; b < 2; ++b)
#pragma unroll
            for (int m = 0; m < 4; ++m)
#pragma unroll
                for (int n = 0; n < 2; ++n) acc[a][b][m][n] = (f32x4){0.f, 0.f, 0.f, 0.f};
    bf16x8 At[4][2], B0[2][2], B1[2][2];
    const char* cA = cur.a; const char* cB = cur.b;
    LAS float* rstab = (LAS float*)(lds + LDS_TAB);
    if constexpr (Epi::USE_RS) { if (tid < 256) rstab[tid] = row_rs(E.SS, cur.pm * BM + tid); }
    PG8_STAGE(PG8_SB(0, 0), cB, voffB); PG8_STAGE(PG8_SB(0, 1), cB + hstepB, voffB); PG8_STAGE(PG8_SA(0, 0), cA, voffA); PG8_STAGE(PG8_SA(0, 1), cA + hstepA, voffA);
    if (wr == 1) PG8_BAR;
    PG8_WAIT_V(2); PG8_BAR;
    PG8_STAGE(PG8_SB(1, 0), cB + kstep, voffB); PG8_STAGE(PG8_SA(1, 0), cA + kstep, voffA); PG8_STAGE(PG8_SB(1, 1), cB + hstepB + kstep, voffB);
    PG8_WAIT_V(6); PG8_BAR;
    for (;;) {
        const bool has_next = S.next(ui + 1, nxt);
        const char* nA = has_next ? nxt.a : cA; const char* nB = has_next ? nxt.b : cB;
        const int nt = cur.nt;
        for (int t = 0; t < nt; t += 2) {
            const bool last = (t == nt - 2);
            const char* a1 = cA + (size_t)(t + 1) * kstep;
            const char* a2 = last ? nA : cA + (size_t)(t + 2) * kstep; const char* b2 = last ? nB : cB + (size_t)(t + 2) * kstep;
            const char* a3 = a2 + kstep; const char* b3 = b2 + kstep;
            PG8_LDB(B0, 0, 0); PG8_LDB(B1, 0, 1); PG8_SCHED; PG8_LDA(At, 0, 0); PG8_STAGE(PG8_SA(1, 1), a1 + hstepA, voffA);
            PG8_WAIT_V(8); PG8_WAIT_L(0); PG8_BAR; PG8_MMA(0, 0, At, B0); PG8_MMA(0, 1, At, B1); PG8_BAR; PG8_SCHED;
            PG8_LDA(At, 0, 1); PG8_STAGE(PG8_SB(0, 0), b2, voffB); PG8_STAGE(PG8_SB(0, 1), b2 + hstepB, voffB); PG8_STAGE(PG8_SA(0, 0), a2, voffA);
            PG8_WAIT_V(8); PG8_WAIT_L(0); PG8_BAR; PG8_MMA(1, 0, At, B0); PG8_MMA(1, 1, At, B1); PG8_BAR; PG8_SCHED;
            PG8_LDB(B0, 1, 0); PG8_LDB(B1, 1, 1); PG8_SCHED; PG8_LDA(At, 1, 0); PG8_STAGE(PG8_SA(0, 1), a2 + hstepA, voffA);
            PG8_WAIT_V(8); PG8_WAIT_L(0); PG8_BAR; PG8_MMA(0, 0, At, B0); PG8_MMA(0, 1, At, B1); PG8_BAR; PG8_SCHED;
            PG8_LDA(At, 1, 1); PG8_STAGE(PG8_SB(1, 0), b3, voffB); PG8_STAGE(PG8_SB(1, 1), b3 + hstepB, voffB); PG8_STAGE(PG8_SA(1, 0), a3, voffA);
            PG8_WAIT_V(8); PG8_WAIT_L(0); PG8_BAR; PG8_MMA(1, 0, At, B0); PG8_MMA(1, 1, At, B1); PG8_BAR; PG8_SCHED;
        }
        if (wr == 0) PG8_BAR;
#ifdef PROBE_CLASS
        unsigned long long pe0 = 0; if (probe) { asm volatile("s_waitcnt vmcnt(0)" ::: "memory"); pe0 = __builtin_amdgcn_s_memrealtime(); }
#endif
        f32x4 ssn = (f32x4){0.f, 0.f, 0.f, 0.f};
        if constexpr (Epi::USE_RS) { if (has_next && tid < 256) ssn = *(const f32x4*)(E.SS + (size_t)(nxt.pm * BM + tid) * 4); }
        E(acc, cur, wr, wc, fr, fq, rstab + (ui & 1) * 256);
        if constexpr (Epi::USE_RS) { if (has_next && tid < 256) rstab[((ui + 1) & 1) * 256 + tid] = __builtin_amdgcn_rsqf(((ssn.x + ssn.y) + (ssn.z + ssn.w)) * (1.0f / DM) + EPS); }
#ifdef PROBE_CLASS
        if (probe) { asm volatile("s_waitcnt vmcnt(0)" ::: "memory"); if (blockIdx.x == 0 && threadIdx.x == 0) *probe += __builtin_amdgcn_s_memrealtime() - pe0; }
#endif
        if (!has_next) break;
#pragma unroll
        for (int a = 0; a < 2; ++a)
#pragma unroll
            for (int b = 0; b < 2; ++b)
#pragma unroll
                for (int m = 0; m < 4; ++m)
#pragma unroll
                    for (int n = 0; n < 2; ++n) acc[a][b][m][n] = (f32x4){0.f, 0.f, 0.f, 0.f};
        cur = nxt; cA = nA; cB = nB; ++ui;
        if (wr == 1) PG8_BAR;
    }
    PG8_WAIT_V(0);
    PG8_BAR;
#undef PG8_SA
#undef PG8_SB
#undef PG8_STAGE
#undef PG8_LDA
#undef PG8_LDB
#undef PG8_MMA
#undef PG8_WAIT_V
#undef PG8_WAIT_L
#undef PG8_BAR
#undef PG8_SCHED
}
}

#define LDS_WAIT() asm volatile("s_waitcnt lgkmcnt(0)" ::: "memory")
__device__ __forceinline__ void transpose_item(const float* W, int N, bf16_t* WT, int K, int k0, int n0, int r0, LAS float* scr, int lane) {
    float wv[32];
#pragma unroll
    for (int i = 0; i < 32; ++i) wv[i] = W[(size_t)(k0 + 2 * i + (lane >> 5)) * N + n0 + (lane & 31)];
#pragma unroll
    for (int i = 0; i < 32; ++i) scr[(2 * i + (lane >> 5)) * 33 + (lane & 31)] = wv[i];
    LDS_WAIT();
    const int c = lane & 7;
#pragma unroll
    for (int j = 0; j < 4; ++j) { const int n = (lane >> 3) + 8 * j; const LAS float* s = scr + (8 * c) * 33 + n;
        u32x4 o; o.x = cvt_pk_bf16(s[0 * 33], s[1 * 33]); o.y = cvt_pk_bf16(s[2 * 33], s[3 * 33]); o.z = cvt_pk_bf16(s[4 * 33], s[5 * 33]); o.w = cvt_pk_bf16(s[6 * 33], s[7 * 33]);
        *(u32x4*)(WT + (size_t)(r0 + n) * K + k0 + 8 * c) = o; }
    LDS_WAIT();
}
__device__ __forceinline__ void convert_matrix(const float* W, int K, int N, int half, bf16_t* WT, int item, LAS float* scr, int lane) {
    const int nblk = N / 32, kb = item / nblk, nb = item % nblk, r0 = nb * 32;
    const int n0 = half ? (((r0 >> 7) & 1) * half + (r0 >> 8) * 128 + (r0 & 127)) : r0;
    transpose_item(W, N, WT, K, kb * 64, n0, r0, scr, lane);
}

__device__ __forceinline__ void phase_prologue(KP p, LAS unsigned char* lds, int gw, int ngw, int wave, int lane) {
    LAS float* scr = (LAS float*)(lds + wave * 16384);
    unsigned char* ws = p->ws;
    constexpr int I_FIN = 16 * 176, I_FDN = 44 * 32, I_AIN = 16 * 64, I_SQ = 16 * 32, I_BIN = 16 * 96, I_D = 4 * 8;
    constexpr int NITEMS = 8 * I_FIN + 8 * I_FDN + I_AIN + I_SQ + I_BIN + I_SQ + I_AIN + I_SQ + 4 * I_D;
    for (int it = gw; it < NITEMS; it += ngw) {
        int r = it;
        if (r < 8 * I_FIN) { const int m = r / I_FIN; if (m >= 1) continue;
            convert_matrix(p->in[6] + (size_t)m * DM * 2 * DFF, DM, 2 * DFF, DFF, (bf16_t*)(ws + WS_W_FFN_IN + m * SZ_FFN_IN), r % I_FIN, scr, lane); continue; } r -= 8 * I_FIN;
        if (r < 8 * I_FDN) { const int m = r / I_FDN; if (m == 1 || (m >= 2 && (r % I_FDN) < 1280)) continue;
            convert_matrix(p->in[7] + (size_t)m * DFF * DM, DFF, DM, 0, (bf16_t*)(ws + WS_W_FFN_DN + m * SZ_FFN_DN), r % I_FDN, scr, lane); continue; } r -= 8 * I_FDN;
        if (r < I_AIN + I_SQ) continue;
        r -= I_AIN + I_SQ;
        if (r < I_BIN + I_SQ + I_AIN + I_SQ + 4 * I_D) continue;
        if (r < I_BIN) {
            const int nblk = 96, kb = r / nblk, nb = r % nblk, r0 = nb * 32;
            const int n0 = (r0 < 2048) ? (1024 + ((r0 >> 7) & 1) * 1024 + (r0 >> 8) * 128 + (r0 & 127)) : (r0 - 2048);
            transpose_item(p->in[14], 3072, (bf16_t*)(ws + WS_W_B_IN), DM, kb * 64, n0, r0, scr, lane); continue; } r -= I_BIN;
        if (r < I_SQ) { convert_matrix(p->in[16], DM, DM, 0, (bf16_t*)(ws + WS_W_B_OUT), r, scr, lane); continue; } r -= I_SQ;
        if (r < I_AIN) { convert_matrix(p->in[17], DM, 2048, 0, (bf16_t*)(ws + WS_W_C_IN), r, scr, lane); continue; } r -= I_AIN;
        if (r < I_SQ) { convert_matrix(p->in[22], DM, DM, 0, (bf16_t*)(ws + WS_W_C_OUT), r, scr, lane); continue; } r -= I_SQ;
        { const int g = r / I_D; convert_matrix(p->in[23] + (size_t)g * 65536, 256, 256, 0, (bf16_t*)(ws + WS_W_D) + (size_t)g * 65536, r % I_D, scr, lane); }
    }
    bf16_t* hb = (bf16_t*)(ws + WS_HB); const float* g0 = p->in[5];
    for (int t = gw; t < NTOK; t += ngw) {
        const float* src = (t < TP) ? p->in[0] + (size_t)t * DM : p->in[1] + (size_t)(t - TP) * DM;
        const f32x4* xr = (const f32x4*)src + lane; f32x4 v[4]; float ss = 0.f;
#pragma unroll
        for (int j = 0; j < 4; ++j) { v[j] = xr[64 * j]; ss += (v[j].x * v[j].x + v[j].y * v[j].y) + (v[j].z * v[j].z + v[j].w * v[j].w); }
        ss = wave_sum(ss);
        if (lane == 0) *(f32x4*)((float*)(ws + WS_SS) + (size_t)t * 4) = (f32x4){ss, 0.f, 0.f, 0.f};
        u32x2* ob = (u32x2*)(hb + (size_t)t * DM) + lane;
#pragma unroll
        for (int j = 0; j < 4; ++j) { const f32x4 g = ((const f32x4*)g0)[lane + 64 * j]; const f32x4 x = v[j] * g;
            u32x2 w; w.x = cvt_pk_bf16(x.x, x.y); w.y = cvt_pk_bf16(x.z, x.w); ob[64 * j] = w; }
    }
}

__device__ __forceinline__ void convert_mixer_weights(KP p, int nl, LAS unsigned char* lds, int gwx, int ngwx, int wave, int lane) {
    LAS float* scr = (LAS float*)(lds + wave * 16384); unsigned char* ws = p->ws;
    constexpr int I_AIN = 16 * 64, I_SQ = 16 * 32, I_BIN = 16 * 96, I_D = 4 * 8;
    const int n = (nl == 1) ? I_BIN + I_SQ : (nl == 2 ? I_AIN + I_SQ : 4 * I_D);
    for (int it = gwx; it < n; it += ngwx) { int r = it;
        if (nl == 1) {
            if (r < I_BIN) { const int nblk = 96, kb = r / nblk, nb = r % nblk, r0 = nb * 32;
                const int n0 = (r0 < 2048) ? (1024 + ((r0 >> 7) & 1) * 1024 + (r0 >> 8) * 128 + (r0 & 127)) : (r0 - 2048);
                transpose_item(p->in[14], 3072, (bf16_t*)(ws + WS_W_B_IN), DM, kb * 64, n0, r0, scr, lane); }
            else convert_matrix(p->in[16], DM, DM, 0, (bf16_t*)(ws + WS_W_B_OUT), r - I_BIN, scr, lane);
        } else if (nl == 2) {
            if (r < I_AIN) convert_matrix(p->in[17], DM, 2048, 0, (bf16_t*)(ws + WS_W_C_IN), r, scr, lane);
            else convert_matrix(p->in[22], DM, DM, 0, (bf16_t*)(ws + WS_W_C_OUT), r - I_AIN, scr, lane);
        } else { const int g = r / I_D; convert_matrix(p->in[23] + (size_t)g * 65536, 256, 256, 0, (bf16_t*)(ws + WS_W_D) + (size_t)g * 65536, r % I_D, scr, lane); }
    }
}
__device__ __forceinline__ void convert_ffn_in_layer(KP p, int nl, LAS unsigned char* lds, int gwx, int ngwx, int wave, int lane) {
    LAS float* scr = (LAS float*)(lds + wave * 16384);
    constexpr int I_FIN = 16 * 176;
    for (int it = gwx; it < 2 * I_FIN; it += ngwx) { const int m = 2 * nl + it / I_FIN;
        convert_matrix(p->in[6] + (size_t)m * DM * 2 * DFF, DM, 2 * DFF, DFF, (bf16_t*)(p->ws + WS_W_FFN_IN + m * SZ_FFN_IN), it % I_FIN, scr, lane); }
}

__device__ __forceinline__ void phase_resnorm_sample(float* h, const float* hsrc, const float* F, const float* FX, int ns, float scale, const float* gA, const float* gB,
                                                     bf16_t* hb, float* SS, int last, int gw, int ngw, int lane) {
    for (int t = TP + gw; t < NTOK; t += ngw) {
        const f32x4* fr = (const f32x4*)(F + (size_t)t * DM) + lane; f32x4 f[4];
#pragma unroll
        for (int j = 0; j < 4; ++j) f[j] = fr[64 * j];
#pragma unroll
        for (int zb = 0; zb < 2; ++zb) { f32x4 tmp[5][4];
#pragma unroll
            for (int k = 0; k < 5; ++k) { const int z = 1 + zb * 5 + k; const f32x4* xr = (const f32x4*)(FX + ((size_t)((z < ns ? z : 1) - 1) * TS + (t - TP)) * DM) + lane;
#pragma unroll
                for (int j = 0; j < 4; ++j) tmp[k][j] = xr[64 * j]; }
#pragma unroll
            for (int k = 0; k < 5; ++k) { const float fac = (1 + zb * 5 + k < ns) ? 1.0f : 0.0f;
#pragma unroll
                for (int j = 0; j < 4; ++j) f[j] += tmp[k][j] * fac; } }
        float ss = 0.f;
#pragma unroll
        for (int j = 0; j < 4; ++j) ss += (f[j].x * f[j].x + f[j].y * f[j].y) + (f[j].z * f[j].z + f[j].w * f[j].w);
        const float rs = scale / sqrtf(wave_sum(ss) * (1.0f / DM) + EPS);
        f32x4* hr = (f32x4*)(h + (size_t)t * DM) + lane; const f32x4* hs = (const f32x4*)(hsrc + (size_t)t * DM) + lane; f32x4 hv[4]; float s2 = 0.f;
#pragma unroll
        for (int j = 0; j < 4; ++j) { const f32x4 g = ((const f32x4*)gA)[lane + 64 * j]; hv[j] = hs[64 * j] + f[j] * rs * g; hr[64 * j] = hv[j];
            s2 += (hv[j].x * hv[j].x + hv[j].y * hv[j].y) + (hv[j].z * hv[j].z + hv[j].w * hv[j].w); }
        if (!last) {
            s2 = wave_sum(s2);
            if (lane == 0) *(f32x4*)(SS + (size_t)t * 4) = (f32x4){s2, 0.f, 0.f, 0.f};
            u32x2* ob = (u32x2*)(hb + (size_t)t * DM) + lane;
#pragma unroll
            for (int j = 0; j < 4; ++j) { const f32x4 g = ((const f32x4*)gB)[lane + 64 * j]; const f32x4 x = hv[j] * g;
                u32x2 w; w.x = cvt_pk_bf16(x.x, x.y); w.y = cvt_pk_bf16(x.z, x.w); ob[64 * j] = w; }
        }
    }
}

__device__ __forceinline__ void phase_conv(KP p, const float* glu, bf16_t* yb, LAS unsigned char* lds, int c, int G, int wave, int lane) {
    const float* state_a = p->in[2]; const float* cw = p->in[9]; const float* cbias = p->in[10]; const float* lg = p->in[11]; const float* lb = p->in[12];
    LAS float* buf = (LAS float*)lds;
    const int ch = wave * 128 + lane * 2;
    f32x2 w[31];
#pragma unroll
    for (int j = 0; j < 31; ++j) w[j] = *(const f32x2*)(cw + j * DM + ch);
    const f32x2 bias = *(const f32x2*)(cbias + ch);
    for (int gp = c; gp < NTOK / 8; gp += G) {
#pragma unroll 1
        for (int gsel = 0; gsel < 2; ++gsel) {
            const int t0 = 8 * gp + 4 * gsel; const bool samp = t0 >= TP;
            const int b = samp ? ((t0 - TP) >> 2) : (t0 >> 11), s0 = samp ? 0 : (t0 & 2047);
            f32x2 acc[4] = {bias, bias, bias, bias};
#pragma unroll
            for (int r = 0; r < 34; ++r) {
                const int rel = r - 30;
                const float* ptr; float fac = 1.0f;
                if (rel >= 0) ptr = glu + (size_t)(t0 + rel) * DM;
                else if (samp) ptr = state_a + ((size_t)b * 30 + 30 + rel) * DM;
                else { const bool ok = (s0 + rel >= 0); ptr = glu + (size_t)(ok ? t0 + rel : t0) * DM; fac = ok ? 1.0f : 0.0f; }
                f32x2 x = *(const f32x2*)(ptr + ch); if (rel < 0) x = x * fac;
#pragma unroll
                for (int o = 0; o < 4; ++o) { const int j = r - o; if (j >= 0 && j <= 30) acc[o] += w[j] * x; }
            }
#pragma unroll
            for (int o = 0; o < 4; ++o) *(LAS f32x2*)(buf + (gsel * 4 + o) * DM + ch) = acc[o];
        }
        __syncthreads();
        {
            const int t = 8 * gp + wave; const LAS f32x4* br = (const LAS f32x4*)(buf + wave * DM) + lane; f32x4 v[4]; float s = 0.f;
#pragma unroll
            for (int j = 0; j < 4; ++j) { v[j] = br[64 * j]; s += (v[j].x + v[j].y) + (v[j].z + v[j].w); }
            const float mean = wave_sum(s) * (1.0f / DM); float s2 = 0.f;
#pragma unroll
            for (int j = 0; j < 4; ++j) { v[j] = v[j] - mean; s2 += (v[j].x * v[j].x + v[j].y * v[j].y) + (v[j].z * v[j].z + v[j].w * v[j].w); }
            const float rstd = 1.0f / sqrtf(wave_sum(s2) * (1.0f / DM) + EPS);
            u32x2* ob = (u32x2*)(yb + (size_t)t * DM) + lane;
#pragma unroll
            for (int j = 0; j < 4; ++j) { const f32x4 g = ((const f32x4*)lg)[lane + 64 * j], bb = ((const f32x4*)lb)[lane + 64 * j]; f32x4 y = v[j] * rstd * g + bb;
#pragma unroll
                for (int e = 0; e < 4; ++e) y[e] = y[e] * sigmoid_f(y[e]);
                u32x2 o; o.x = cvt_pk_bf16(y.x, y.y); o.y = cvt_pk_bf16(y.z, y.w); ob[64 * j] = o; }
        }
        __syncthreads();
    }
    const int gw = c * NWAVES + wave, ngw = G * NWAVES;
    for (int it = gw; it < (8 + 128) * 30; it += ngw) {
        const float* src; float* dst;
        if (it < 240) { const int b = it / 30, r = it % 30; src = glu + ((size_t)b * 2048 + 2018 + r) * DM; dst = p->out + O_SA_P + (size_t)it * DM; }
        else { const int e = it - 240, b = e / 30, r = e % 30; src = (r < 26) ? state_a + ((size_t)b * 30 + r + 4) * DM : glu + ((size_t)TP + b * 4 + r - 26) * DM; dst = p->out + O_SA_S + (size_t)e * DM; }
#pragma unroll
        for (int j = 0; j < 4; ++j) ((f32x4*)dst + lane)[64 * j] = ((const f32x4*)src + lane)[64 * j];
    }
}

__device__ __forceinline__ void phase_gate(KP p, const float* z, const float* bg, bf16_t* yb, int gw, int ngw, int lane) {
    const float* state_b = p->in[3]; const float* cw = p->in[15];
    for (int t = gw; t < NTOK; t += ngw) {
        const bool samp = t >= TP; const int b = samp ? ((t - TP) >> 2) : (t >> 11), s = samp ? ((t - TP) & 3) : (t & 2047);
        const float* r2 = z + (size_t)t * DM;
        const float* r1; const float* r0; float f1 = 1.f, f0 = 1.f;
        if (s >= 1) r1 = z + (size_t)(t - 1) * DM; else if (samp) r1 = state_b + ((size_t)b * 2 + 1) * DM; else { r1 = r2; f1 = 0.f; }
        if (s >= 2) r0 = z + (size_t)(t - 2) * DM; else if (samp) r0 = state_b + ((size_t)b * 2 + s) * DM; else { r0 = r2; f0 = 0.f; }
        u32x2* ob = (u32x2*)(yb + (size_t)t * DM) + lane;
        float* st = nullptr;
        if (!samp && s >= 2046) st = p->out + O_SB_P + ((size_t)b * 2 + (s - 2046)) * DM;
        if (samp && s >= 2) st = p->out + O_SB_S + ((size_t)b * 2 + (s - 2)) * DM;
#pragma unroll
        for (int j = 0; j < 4; ++j) {
            const f32x4 z2 = ((const f32x4*)r2 + lane)[64 * j], z1 = ((const f32x4*)r1 + lane)[64 * j] * f1, z0 = ((const f32x4*)r0 + lane)[64 * j] * f0;
            const f32x4 w0 = ((const f32x4*)cw + lane)[64 * j], w1 = ((const f32x4*)(cw + DM) + lane)[64 * j], w2 = ((const f32x4*)(cw + 2 * DM) + lane)[64 * j];
            const f32x4 g = ((const f32x4*)(bg + (size_t)t * DM) + lane)[64 * j];
            const f32x4 y = g * (w0 * z0 + w1 * z1 + w2 * z2);
            u32x2 o; o.x = cvt_pk_bf16(y.x, y.y); o.y = cvt_pk_bf16(y.z, y.w); ob[64 * j] = o;
            if (st) ((f32x4*)st + lane)[64 * j] = z2;
        }
    }
}

__device__ __forceinline__ void phase_vln(KP p, const float* zz, bf16_t* vn, int gw, int ngw, int lane) {
    const float* lg = p->in[18]; const float* lb = p->in[19];
    for (int t = gw; t < NTOK; t += ngw) {
        const f32x4* vr = (const f32x4*)(zz + (size_t)t * 2048 + 1024) + lane; f32x4 v[4]; float s = 0.f;
#pragma unroll
        for (int j = 0; j < 4; ++j) { v[j] = vr[64 * j]; s += (v[j].x + v[j].y) + (v[j].z + v[j].w); }
        const float mean = wave_sum(s) * (1.0f / DM); float s2 = 0.f;
#pragma unroll
        for (int j = 0; j < 4; ++j) { v[j] = v[j] - mean; s2 += (v[j].x * v[j].x + v[j].y * v[j].y) + (v[j].z * v[j].z + v[j].w * v[j].w); }
        const float rstd = 1.0f / sqrtf(wave_sum(s2) * (1.0f / DM) + EPS);
        u32x2* ob = (u32x2*)(vn + (size_t)t * DM) + lane;
#pragma unroll
        for (int j = 0; j < 4; ++j) { const f32x4 g = ((const f32x4*)lg)[lane + 64 * j], bb = ((const f32x4*)lb)[lane + 64 * j]; const f32x4 y = v[j] * rstd * g + bb;
            u32x2 o; o.x = cvt_pk_bf16(y.x, y.y); o.y = cvt_pk_bf16(y.z, y.w); ob[64 * j] = o;
            if (t >= TP) ((f32x4*)(p->out + O_SC_S + (size_t)(t - TP) * DM) + lane)[64 * j] = y; }
    }
}

__device__ __forceinline__ void phase_spatial(KP p, const float* zz, const float* vst, bf16_t* yb, LAS unsigned char* lds, int c, int G, int tid, int wave, int lane) {
    const float* wsp = p->in[20]; const float* bsp = p->in[21];
    constexpr int LD = 136;
    LAS bf16_t* WmL = (LAS bf16_t*)lds; LAS bf16_t* VT = (LAS bf16_t*)(lds + 128 * LD * 2); LAS f32x2* MR = (LAS f32x2*)(lds + 2 * 128 * LD * 2);
    const int hh = c & 7;
    const int cp = tid & 15;
    const f32x4 ga0 = *(const f32x4*)(p->in[18] + hh * 128 + cp * 8), ga1 = *(const f32x4*)(p->in[18] + hh * 128 + cp * 8 + 4);
    const f32x4 ba0 = *(const f32x4*)(p->in[19] + hh * 128 + cp * 8), ba1 = *(const f32x4*)(p->in[19] + hh * 128 + cp * 8 + 4);
    int wm_variant = -1;
    for (int u = c; u < 132 * 8; u += G) {
        const int h = u & 7, cu = u >> 3; const bool samp = cu >= 128; const int tok0 = samp ? TP + (cu - 128) * 128 : cu * 128;
        if (tid < 128) { const f32x4* q = (const f32x4*)(vst + (size_t)(tok0 + tid) * 32); float s1 = 0.f, s2 = 0.f;
#pragma unroll
            for (int k = 0; k < 8; ++k) { const f32x4 w = q[k]; s1 += w.x + w.z; s2 += w.y + w.w; }
            const float mean = s1 * (1.0f / DM), var = s2 * (1.0f / DM) - mean * mean;
            MR[tid] = (f32x2){mean, __builtin_amdgcn_rsqf(fmaxf(var, 0.f) + EPS)}; }
        const int variant = (h << 1) | (samp ? 1 : 0);
        if (variant != wm_variant) {
            f32x2 ww[16];
#pragma unroll
            for (int k = 0; k < 16; ++k) { const int idx = tid + 512 * k, i = idx >> 6, j2 = (idx & 63) * 2;
                ww[k] = *(const f32x2*)(wsp + (size_t)h * 16384 + (samp ? (i & 3) * 128 + (j2 & 3) : i * 128 + j2)); }
#pragma unroll
            for (int k = 0; k < 16; ++k) { const int idx = tid + 512 * k, i = idx >> 6, j2 = (idx & 63) * 2;
                bool k0, k1;
                if (!samp) { k0 = (j2 <= i); k1 = (j2 + 1 <= i); }
                else { const bool same = (i >> 2) == (j2 >> 2); const int ti = i & 3, tj = j2 & 3; k0 = same && tj <= ti; k1 = same && tj + 1 <= ti; }
                *(LAS unsigned*)(WmL + i * LD + j2) = cvt_pk_bf16(k0 ? ww[k].x : 0.f, k1 ? ww[k].y : 0.f); } }
        wm_variant = variant;
        __syncthreads();
#pragma unroll
        for (int k = 0; k < 4; ++k) { const int j = (tid + 512 * k) >> 4;
            const float* vp = zz + (size_t)(tok0 + j) * 2048 + 1024 + h * 128 + cp * 8;
            const f32x4 v0 = *(const f32x4*)vp, v1 = *(const f32x4*)(vp + 4); const f32x2 mr = MR[j];
            const f32x4 y0 = (v0 - mr.x) * mr.y * ga0 + ba0, y1 = (v1 - mr.x) * mr.y * ga1 + ba1;
            if (samp) { float* so = p->out + O_SC_S + (size_t)(tok0 + j - TP) * DM + h * 128 + cp * 8; *(f32x4*)so = y0; *(f32x4*)(so + 4) = y1; }
            const unsigned p0 = cvt_pk_bf16(y0.x, y0.y), p1 = cvt_pk_bf16(y0.z, y0.w), p2 = cvt_pk_bf16(y1.x, y1.y), p3 = cvt_pk_bf16(y1.z, y1.w);
            LAS bf16_t* d = VT + (cp * 8) * LD + j;
            d[0 * LD] = (bf16_t)(p0 & 0xffff); d[1 * LD] = (bf16_t)(p0 >> 16); d[2 * LD] = (bf16_t)(p1 & 0xffff); d[3 * LD] = (bf16_t)(p1 >> 16);
            d[4 * LD] = (bf16_t)(p2 & 0xffff); d[5 * LD] = (bf16_t)(p2 >> 16); d[6 * LD] = (bf16_t)(p3 & 0xffff); d[7 * LD] = (bf16_t)(p3 >> 16); }
        __syncthreads();
        const int i0 = 16 * wave, fr = lane & 15, fq = lane >> 4;
        f32x4 acc[8];
#pragma unroll
        for (int cb = 0; cb < 8; ++cb) acc[cb] = (f32x4){0.f, 0.f, 0.f, 0.f};
        const int nks = (i0 + 15) / 32 + 1;
        for (int ks = 0; ks < nks; ++ks) {
            const bf16x8 wf = *(const LAS bf16x8*)(WmL + (i0 + fr) * LD + ks * 32 + 8 * fq);
#pragma unroll
            for (int cb = 0; cb < 8; ++cb) { const bf16x8 vf = *(const LAS bf16x8*)(VT + (cb * 16 + fr) * LD + ks * 32 + 8 * fq);
                acc[cb] = __builtin_amdgcn_mfma_f32_16x16x32_bf16(vf, wf, acc[cb], 0, 0, 0); }
        }
        const int i = i0 + fr, tok = tok0 + i; const float bsv = bsp[h * 128 + (samp ? (i & 3) : i)];
#pragma unroll
        for (int cb = 0; cb < 8; ++cb) { const int col = h * 128 + cb * 16 + fq * 4;
            const f32x4 uu = *(const f32x4*)(zz + (size_t)tok * 2048 + col); const f32x4 y = uu * (acc[cb] + bsv);
            u32x2 o; o.x = cvt_pk_bf16(y.x, y.y); o.y = cvt_pk_bf16(y.z, y.w); *(u32x2*)(yb + (size_t)tok * DM + col) = o; }
        __syncthreads();
    }
    (void)hh;
}

__device__ __forceinline__ f32x4 bf4_to_f32(u32x2 v) { f32x4 r; r.x = __uint_as_float(v.x << 16); r.y = __uint_as_float(v.x & 0xffff0000u); r.z = __uint_as_float(v.y << 16); r.w = __uint_as_float(v.y & 0xffff0000u); return r; }
__device__ __forceinline__ void pool_token(KP p, const bf16_t* hbn, const float* SS, bf16_t* yb, int t, int lane) {
    const float* state_p = p->in[4];
    const int b = (t - TP) >> 2, s = (t - TP) & 3;
    u32x2* ob = (u32x2*)(yb + (size_t)t * DM) + lane;
    float rsd[4];
#pragma unroll
    for (int d = 0; d < 4; ++d) rsd[d] = (d <= s) ? pg8::row_rs(SS, t - (d <= s ? d : 0)) : 0.f;
#pragma unroll
    for (int j = 0; j < 4; ++j) {
        const int w = 2 << j; const f32x4 x0 = bf4_to_f32(((const u32x2*)(hbn + (size_t)t * DM) + lane)[64 * j]) * rsd[0]; f32x4 sum = x0;
#pragma unroll
        for (int d = 1; d < w; ++d) {
            if (d < 4) sum += bf4_to_f32(((const u32x2*)(hbn + (size_t)(t - (d <= s ? d : 0)) * DM) + lane)[64 * j]) * rsd[d];
            const int si = 15 + s - d;
            sum += ((const f32x4*)(state_p + ((size_t)b * 15 + (si > 14 ? 14 : si)) * DM) + lane)[64 * j] * ((d > s) ? 1.0f : 0.0f);
        }
        const f32x4 y = sum * (1.0f / (float)w) - x0;
        u32x2 o; o.x = cvt_pk_bf16(y.x, y.y); o.y = cvt_pk_bf16(y.z, y.w); ob[64 * j] = o;
    }
}
__device__ __forceinline__ void pool_state_rows(KP p, const bf16_t* hbn, const float* SS, int gw, int ngw, int lane) {
    const float* state_p = p->in[4];
    for (int it = gw; it < (8 + 128) * 15; it += ngw) {
        const float* src = nullptr; int tt = 0; float* dst;
        if (it < 120) { const int b = it / 15, r = it % 15; tt = b * 2048 + 2033 + r; dst = p->out + O_SP_P + (size_t)it * DM; }
        else { const int e = it - 120, b = e / 15, r = e % 15; if (r < 11) src = state_p + ((size_t)b * 15 + r + 4) * DM; else tt = TP + b * 4 + r - 11; dst = p->out + O_SP_S + (size_t)e * DM; }
        if (src) {
#pragma unroll
            for (int j = 0; j < 4; ++j) ((f32x4*)dst + lane)[64 * j] = ((const f32x4*)src + lane)[64 * j];
        } else { const float rs = pg8::row_rs(SS, tt);
#pragma unroll
            for (int j = 0; j < 4; ++j) ((f32x4*)dst + lane)[64 * j] = bf4_to_f32(((const u32x2*)(hbn + (size_t)tt * DM) + lane)[64 * j]) * rs; }
    }
}
__device__ __forceinline__ void pool_tile_prompt(const bf16_t* hbn, const float* SS, bf16_t* yb, LAS unsigned char* lds, int pm, int g, int tid) {
    LAS float* RS = (LAS float*)lds;
    const int t0 = pm * 256, sbase = (pm & 7) * 256;
    for (int k = tid; k < 271; k += NTHREADS) RS[k] = (sbase - 15 + k >= 0) ? pg8::row_rs(SS, t0 - 15 + k) : 0.f;
    __syncthreads();
    const int w = 2 << g, r0 = (tid >> 5) * 16; const size_t colb = (size_t)g * 256 + (tid & 31) * 8;
    f32x4 sa = (f32x4){0.f, 0.f, 0.f, 0.f}, sb = sa;
#define POOL_LDX(r_, a_, b_) do { const u32x4 v_ = *(const u32x4*)(hbn + (size_t)(t0 + (r_)) * DM + colb); const float rs_ = RS[(r_) + 15]; \
        a_ = bf4_to_f32((u32x2){v_.x, v_.y}) * rs_; b_ = bf4_to_f32((u32x2){v_.z, v_.w}) * rs_; } while (0)
    for (int d = 1; d < w; ++d) { const int r = r0 - d; if (sbase + r >= 0) { f32x4 a, b; POOL_LDX(r, a, b); sa += a; sb += b; } }
    for (int i = 0; i < 16; ++i) { const int r = r0 + i, s = sbase + r; f32x4 a, b; POOL_LDX(r, a, b); sa += a; sb += b;
        const float inv = 1.0f / (float)((s + 1 < w) ? s + 1 : w);
        const f32x4 ya = sa * inv - a, yc = sb * inv - b;
        u32x4 o; o.x = cvt_pk_bf16(ya.x, ya.y); o.y = cvt_pk_bf16(ya.z, ya.w); o.z = cvt_pk_bf16(yc.x, yc.y); o.w = cvt_pk_bf16(yc.z, yc.w);
        *(u32x4*)(yb + (size_t)(t0 + r) * DM + colb) = o;
        const int ro = r - w + 1; if (sbase + ro >= 0) { f32x4 a2, b2; POOL_LDX(ro, a2, b2); sa -= a2; sb -= b2; } }
#undef POOL_LDX
}

__global__ void __launch_bounds__(NTHREADS, 2) mega_fwd(Params p_unused) {
    extern __shared__ __attribute__((aligned(16))) unsigned char shm[];
    LAS unsigned char* lds = (LAS unsigned char*)shm;
    cg::grid_group grid = cg::this_grid();
    volatile LAS unsigned* st = (volatile LAS unsigned*)(lds + 131072);
    if (threadIdx.x == 0) { st[0] = 0u; st[1] = 0u; st[2] = 0u; st[3] = 0u; }
    __syncthreads();
    XcdBarrier bar;
#ifdef PROBE_CLASS
    unsigned long long pr_acc = 0, pr_t0 = __builtin_amdgcn_s_memrealtime();
#define PR_BEGIN() pr_t0 = __builtin_amdgcn_s_memrealtime()
#define PR_END(cond) do { if (cond) pr_acc += __builtin_amdgcn_s_memrealtime() - pr_t0; } while (0)
#else
#define PR_BEGIN()
#define PR_END(cond)
#endif
    {
        KP p = (KP)__builtin_amdgcn_kernarg_segment_ptr();
        const int tid = threadIdx.x, lane = tid & 63, wave = __builtin_amdgcn_readfirstlane(tid >> 6);
        const int G = gridDim.x, c = blockIdx.x, gw = c * NWAVES + wave, ngw = G * NWAVES;
        bar = xcd_barrier_post((unsigned*)(p->ws + WS_BAR), st);
        phase_prologue(p, lds, gw, ngw, wave, lane);
    }
    grid.sync();
    PR_END(PROBE_CLASS == 0);

#pragma unroll 1
    for (int ph = 0; ph < NLAYER * 11; ++ph) {
        KP p = (KP)__builtin_amdgcn_kernarg_segment_ptr(); asm volatile("" : "+s"(p));
        int G = gridDim.x, c = blockIdx.x; asm volatile("" : "+s"(G), "+s"(c));
#define PHASE_IDS() int tid = threadIdx.x; asm volatile("" : "+v"(tid)); const int lane = tid & 63, wave = __builtin_amdgcn_readfirstlane(tid >> 6), gw = c * NWAVES + wave, ngw = G * NWAVES; (void)lane; (void)wave; (void)gw; (void)ngw
        unsigned char* ws = p->ws;
        const int layer = ph / 11, step = ph % 11;
        float* h = p->out + O_Y;
        bf16_t* hb = (bf16_t*)(ws + WS_HB);
        bf16_t* act = (bf16_t*)(ws + WS_ACT);
        bf16_t* yb = (bf16_t*)(ws + WS_ACT);
        bf16_t* vn = (bf16_t*)(ws + WS_ACT + (size_t)NTOK * DM * 2);
        float* F = (float*)(ws + WS_F);
        float* FX = (float*)(ws + WS_FX);
        float* MT = (float*)(ws + WS_MT);
        float* SS = (float*)(ws + WS_SS);
        const float* g6 = p->in[5] + (size_t)layer * 6 * DM;
        int kind;
        switch (step) {
            case 0: case 8: kind = 1; break;
            case 1: case 9: case 6: kind = 9; break;
            case 2: case 7: case 10: kind = 0; break;
            case 3: kind = (layer == 0 || layer == 1) ? 1 : (layer == 2 ? 2 : 0); break;
            case 4: kind = (layer == 0) ? 4 : 0; break;
            default: kind = (layer == 1) ? 5 : (layer == 2 ? 7 : 0); break;
        }
        if (kind == 0) continue;
        PR_BEGIN();
        const int rstep = (step == 2 || step == 7 || step == 10) ? step - 1 : step;
        const float* gA = g6 + (rstep == 1 ? 1 : (rstep == 6 ? 3 : 5)) * DM;
        const float* gB = g6 + (rstep == 1 ? 2 : (rstep == 6 ? 4 : 6)) * DM;
        const float rscale = (rstep == 6) ? 1.0f : 0.5f;
        const int rlast = (layer == 3 && rstep == 9) ? 1 : 0;
        const int rns = (rstep == 6) ? ((layer == 3) ? 1 : 4) : 11;
        if (kind == 1) {
            pg8::Sched S; S.A = (const char*)hb; S.lda = DM; S.ldb = DM; S.K = DM; S.ns = 0; S.apn = 0; S.G = G; S.c = c; S.smode = 0;
            pg8::EpiGated E; E.SS = SS; E.pn_plain = 1 << 20; E.OF2 = nullptr; E.pub = nullptr;
            unsigned* pubcnt = (unsigned*)(ws + WS_CNT) + 48;
            if (step != 3) { S.Bt = (const char*)(ws + WS_W_FFN_IN + (size_t)(layer * 2 + (step == 8 ? 1 : 0)) * SZ_FFN_IN); S.nN = 22; E.O = act; E.OF = nullptr; E.ldo = DFF; E.mode = 0; S.smode = 1; E.pub = pubcnt; }
            else { S.Bt = (const char*)(ws + (layer == 0 ? WS_W_A_IN : WS_W_B_IN)); S.nN = 8; E.O = nullptr; E.OF = MT; E.ldo = DM; E.mode = (layer == 0) ? 1 : 2;
                if (layer == 1) { S.nN = 12; E.pn_plain = 8; E.OF2 = MT + (size_t)NTOK * DM; } }
#ifdef PROBE_CLASS
            pg8::gemm_phase(lds, S, E, (PROBE_CLASS == 6 && step != 3) ? (unsigned long long*)(ws + WS_BAR + 15360) : nullptr);
#else
            pg8::gemm_phase(lds, S, E);
#endif
            if (step == 3) { const int nextra = 66 * S.nN - 2 * 256 - (layer == 1 ? 256 : 0);
                if (c >= nextra) { PHASE_IDS(); convert_ffn_in_layer(p, layer + 1, lds, (c - nextra) * NWAVES + wave, (G - nextra) * NWAVES, wave, lane);
                    convert_mixer_weights(p, layer + 1, lds, (c - nextra) * NWAVES + wave, (G - nextra) * NWAVES, wave, lane);
                    if (layer == 0) { LAS float* scr = (LAS float*)(lds + wave * 16384); const int gwx = (c - nextra) * NWAVES + wave, ngwx = (G - nextra) * NWAVES;
                        for (int it = gwx; it < 16 * 176; it += ngwx) convert_matrix(p->in[6] + (size_t)1 * DM * 2 * DFF, DM, 2 * DFF, DFF, (bf16_t*)(ws + WS_W_FFN_IN + 1 * SZ_FFN_IN), it, scr, lane);
                        for (int it = gwx; it < 16 * 32; it += ngwx) convert_matrix(p->in[13], DM, DM, 0, (bf16_t*)(ws + WS_W_A_OUT), it, scr, lane); } } }
            if (step != 3 && c >= 172) {
                PHASE_IDS();
                if (tid == 0) { const unsigned want = 44u * (unsigned)(layer * 2 + (step == 8 ? 2 : 1)); unsigned sp = 0;
                    while (__hip_atomic_load(pubcnt, __ATOMIC_RELAXED, __HIP_MEMORY_SCOPE_AGENT) < want) { __builtin_amdgcn_s_sleep(1); if (++sp > (1u << 22)) break; }
                    __builtin_amdgcn_fence(__ATOMIC_ACQUIRE, "agent"); asm volatile("s_waitcnt vmcnt(0)" ::: "memory"); }
                __syncthreads();
                pg8::Sched S2; S2.A = (const char*)act; S2.Bt = (const char*)(ws + WS_W_FFN_DN + (size_t)(layer * 2 + (step == 8 ? 1 : 0)) * SZ_FFN_DN); S2.lda = DFF; S2.ldb = DFF; S2.nN = 4; S2.K = DFF; S2.ns = 11; S2.apn = 0;
                S2.G = 84; S2.c = c - 172; S2.smode = 3;
                pg8::EpiSlab E2; E2.F = F; E2.FX = FX; E2.SS = nullptr;
                pg8::gemm_phase(lds, S2, E2);
                if (ph == 0 && c >= 176) { LAS float* scr = (LAS float*)(lds + wave * 16384);
                    for (int it = (c - 176) * NWAVES + wave; it < 16 * 64; it += 80 * NWAVES) convert_matrix(p->in[8], DM, 2048, 1024, (bf16_t*)(ws + WS_W_A_IN), it, scr, lane); }
                if (layer < 3 && c >= 176) {
                    const int m = 2 * (layer + 1) + (step == 8 ? 1 : 0); LAS float* scr = (LAS float*)(lds + wave * 16384);
                    for (int it = (c - 176) * NWAVES + wave; it < 1280; it += 80 * NWAVES)
                        convert_matrix(p->in[7] + (size_t)m * DFF * DM, DFF, DM, 0, (bf16_t*)(ws + WS_W_FFN_DN + m * SZ_FFN_DN), it, scr, lane);
                }
            }
        } else if (kind == 2) {
            pg8::Sched S; S.G = G; S.c = c; S.apn = 0; S.ns = 0; S.A = (const char*)hb; S.lda = DM; S.ldb = DM; S.K = DM; S.smode = 0;
            pg8::EpiF32 E; E.SS = SS; E.vst = nullptr;
            if (step == 3) { S.Bt = (const char*)(ws + WS_W_C_IN); S.nN = 8; E.C = MT; E.ldc = 2048; E.act = 1; E.vst = (float*)vn; }
            else { S.Bt = (const char*)(ws + WS_W_B_IN + (size_t)2048 * DM * 2); S.nN = 4; E.C = MT + (size_t)NTOK * DM; E.ldc = DM; E.act = 0; }
            pg8::gemm_phase(lds, S, E);
            if (step == 3 && c >= 16) { PHASE_IDS(); convert_ffn_in_layer(p, layer + 1, lds, (c - 16) * NWAVES + wave, (G - 16) * NWAVES, wave, lane);
                convert_mixer_weights(p, layer + 1, lds, (c - 16) * NWAVES + wave, (G - 16) * NWAVES, wave, lane); }
        } else if (kind == 9) {
            pg8::Sched S; S.G = G; S.c = c; S.apn = 0; S.nN = 4; S.smode = (step != 6) ? 2 : 0;
            pg8::EpiResNorm E; E.h = h; E.hsrc = (ph == 1) ? p->in[0] : h; E.hb = hb; E.SS = SS; E.F = F; E.FX = FX; E.gA = gA; E.gB = gB; E.cscale = nullptr; E.scale = rscale; E.last = rlast;
            E.xbuf = (float*)(ws + WS_XBUF); E.cnt = (unsigned*)(ws + WS_CNT); E.tab = (LAS float*)(lds + LDS_TAB);
            E.target = 32u * (unsigned)(layer * 3 + (step == 1 ? 1 : (step == 6 ? 2 : 3)));
            if (step != 6) { S.A = (const char*)act; S.Bt = (const char*)(ws + WS_W_FFN_DN + (size_t)(layer * 2 + (step == 9 ? 1 : 0)) * SZ_FFN_DN); S.lda = DFF; S.ldb = DFF; S.K = DFF; S.ns = 11; }
            else { S.A = (const char*)(layer == 3 ? (bf16_t*)MT : yb); S.lda = DM;
                if (layer == 3) { S.Bt = (const char*)(ws + WS_W_D); S.ldb = 256; S.K = 256; S.ns = 1; S.apn = 256; E.cscale = p->in[24];
                    PHASE_IDS(); int pm0, pn0; pg8::map_tile(c, 64, 4, pm0, pn0);
                    pool_tile_prompt(hb, SS, (bf16_t*)MT, lds, pm0, pn0, tid);
                    pool_state_rows(p, hb, SS, gw, ngw, lane);
                    asm volatile("s_waitcnt vmcnt(0)" ::: "memory"); __syncthreads(); }
                else { S.Bt = (const char*)(ws + (layer == 0 ? WS_W_A_OUT : (layer == 1 ? WS_W_B_OUT : WS_W_C_OUT))); S.ldb = DM; S.K = DM; S.ns = 4; } }
#ifdef PROBE_CLASS
            pg8::gemm_phase(lds, S, E, (PROBE_CLASS == 7 && step != 6) ? (unsigned long long*)(ws + WS_BAR + 15360) : nullptr);
#else
            pg8::gemm_phase(lds, S, E);
#endif
            {
                PHASE_IDS();
                unsigned* cs = (unsigned*)(ws + WS_CNT) + 32;
                const unsigned starget = 32u * (unsigned)layer + (layer == 3 ? 8u : 32u);
                asm volatile("s_waitcnt vmcnt(0)" ::: "memory");
                __syncthreads();
                if (step == 6 && c < 8 * S.ns && tid == 0) { __builtin_amdgcn_fence(__ATOMIC_RELEASE, "agent"); asm volatile("s_waitcnt vmcnt(0)" ::: "memory"); __hip_atomic_fetch_add(cs, 1u, __ATOMIC_RELAXED, __HIP_MEMORY_SCOPE_AGENT); }
                if (c < 64) {
                    if (step == 6 && tid == 0) { unsigned sp = 0; while (__hip_atomic_load(cs, __ATOMIC_RELAXED, __HIP_MEMORY_SCOPE_AGENT) < starget) { __builtin_amdgcn_s_sleep(1); if (++sp > (1u << 22)) break; }
                        __builtin_amdgcn_fence(__ATOMIC_ACQUIRE, "agent"); asm volatile("s_waitcnt vmcnt(0)" ::: "memory"); }
                    __syncthreads();
                    phase_resnorm_sample(h, (ph == 1) ? p->in[1] - (size_t)TP * DM : h, F, FX, rns, rscale, gA, gB, hb, SS, rlast, gw, 512, lane);
                    if (layer == 3 && step == 1) {
                        asm volatile("s_waitcnt vmcnt(0)" ::: "memory"); __syncthreads();
                        pool_token(p, hb, SS, (bf16_t*)MT, TP + gw, lane);
                    }
                } else if (layer == 0 && step == 6) {
                    LAS float* scr = (LAS float*)(lds + wave * 16384);
                    for (int it = (c - 64) * NWAVES + wave; it < 44 * 32; it += 192 * NWAVES) convert_matrix(p->in[7] + (size_t)1 * DFF * DM, DFF, DM, 0, (bf16_t*)(ws + WS_W_FFN_DN + 1 * SZ_FFN_DN), it, scr, lane);
                }
            }
        } else if (kind == 4) { PHASE_IDS(); phase_conv(p, MT, yb, lds, c, G, wave, lane); }
        else if (kind == 5) { PHASE_IDS(); phase_gate(p, MT, MT + (size_t)NTOK * DM, yb, gw, ngw, lane); }
        else if (kind == 7) { PHASE_IDS(); phase_spatial(p, MT, (const float*)vn, yb, lds, c, G, tid, wave, lane); }
        else { }
        PR_END((PROBE_CLASS == 1 && kind == 1 && step != 3) || (PROBE_CLASS == 2 && kind == 9 && step != 6) || (PROBE_CLASS == 4 && step >= 3 && step <= 6) || (PROBE_CLASS == 5 && kind == 3));
        PR_BEGIN();
        if (ph != NLAYER * 11 - 1) xcd_barrier(bar);
        PR_END(PROBE_CLASS == 3 || (PROBE_CLASS == 4 && step >= 3 && step <= 6));
    }
#ifdef PROBE_CLASS
    if (PROBE_CLASS >= 6) { pr_acc = *(volatile unsigned long long*)(((KP)__builtin_amdgcn_kernarg_segment_ptr())->ws + WS_BAR + 15360); }
    if (blockIdx.x == 0) { const unsigned long long t0 = __builtin_amdgcn_s_memrealtime(); while (__builtin_amdgcn_s_memrealtime() - t0 < pr_acc) __builtin_amdgcn_s_sleep(8); }
#endif
}

extern "C" void kernel_launch(void* const* d_in, const int* in_sizes, int n_in, void* d_out, int out_size, void* d_ws, size_t ws_size, hipStream_t stream) {
    static int grid = 0;
    if (grid == 0) {
        if (n_in != 25 || (size_t)out_size != O_END || ws_size < WS_END) { fprintf(stderr, "kernel_launch: unexpected shapes (n_in %d out %d ws %zu need %zu)\n", n_in, out_size, ws_size, (size_t)WS_END); grid = -1; return; }
        int dev = 0, cus = 0, per_cu = 0;
        hipGetDevice(&dev); hipDeviceGetAttribute(&cus, hipDeviceAttributeMultiprocessorCount, dev);
        hipFuncSetAttribute((const void*)mega_fwd, hipFuncAttributeMaxDynamicSharedMemorySize, LDS_BYTES);
        hipOccupancyMaxActiveBlocksPerMultiprocessor(&per_cu, (const void*)mega_fwd, NTHREADS, LDS_BYTES);
        if (per_cu < 1) { fprintf(stderr, "kernel_launch: occupancy query says %d blocks per CU\n", per_cu); per_cu = 1; }
        (void)hipGetLastError();
        grid = cus;
        if (grid != 256) fprintf(stderr, "kernel_launch: the fused epilogues assume 256 workgroups (got %d CUs)\n", grid);
    }
    if (grid < 0) return;
    hipMemsetAsync((char*)d_ws + WS_BAR, 0, 32768, stream);
    Params p{};
    for (int i = 0; i < 25; ++i) p.in[i] = (const float*)d_in[i];
    p.out = (float*)d_out; p.ws = (unsigned char*)d_ws;
    void* args[] = {&p};
    hipError_t e = hipLaunchCooperativeKernel((const void*)mega_fwd, dim3(grid), dim3(NTHREADS), args, LDS_BYTES, stream);
    if (e != hipSuccess) fprintf(stderr, "cooperative launch failed: %s (grid %d)\n", hipGetErrorString(e), grid);
}
```
